# Optimizing an MI355X kernel written in HIP

```python
import jax, jax.numpy as jnp
from jax import lax
import numpy as np

D_MODEL = 1024
BATCH = 32
SEQ = 2048
DEPTH = 4

N_MIXERS = 2
N_A_LAYERS = (DEPTH + 1) // 2
N_B_LAYERS = DEPTH // 2
D_FF = 2816
CHUNK = 128
A_INNER = D_MODEL
A_GROUPS = 8
A_GROUP_DIM = A_INNER // A_GROUPS
B_HEADS = 16
B_HEAD_DIM = D_MODEL // B_HEADS
Q_BLOCK = 128
RMS_EPS = 1e-6
LN_EPS = 1e-5

kernel_name = "hybrid_gmlp_stickbreak_macaron"


def rms_norm(x, g):
    xf = x.astype(jnp.float32)
    y = xf * lax.rsqrt(jnp.mean(xf * xf, axis=-1, keepdims=True) + RMS_EPS)
    return (y * g.astype(jnp.float32)).astype(x.dtype)


def layer_norm(x, g):
    xf = x.astype(jnp.float32)
    mu = jnp.mean(xf, axis=-1, keepdims=True)
    var = jnp.mean(jnp.square(xf - mu), axis=-1, keepdims=True)
    return ((xf - mu) * lax.rsqrt(var + LN_EPS) * g.astype(jnp.float32)).astype(x.dtype)


def swiglu(x, w_gate, w_up, w_down):
    return (jax.nn.silu(x @ w_gate) * (x @ w_up)) @ w_down


def chunked_gmlp(x, w_in, ln_g, w_s, b_s, w_out):
    bsz, seq, _ = x.shape
    h = jax.nn.gelu(x @ w_in, approximate=False)
    u, v = jnp.split(h, 2, axis=-1)
    v = layer_norm(v, ln_g)
    v = v.reshape(bsz, seq // CHUNK, CHUNK, A_GROUPS, A_GROUP_DIM)
    causal = jnp.tril(jnp.ones((CHUNK, CHUNK), dtype=bool))
    w = jnp.where(causal[None], w_s, 0.0).astype(v.dtype)
    bias = jnp.swapaxes(b_s, 0, 1)[None, None, :, :, None].astype(v.dtype)
    v = jnp.einsum('gts,bcsgd->bctgd', w, v) + bias
    y = u * v.reshape(bsz, seq, A_INNER)
    return y @ w_out


def stick_breaking_attention(x, w_qkv, w_o):
    bsz, seq, _ = x.shape
    qkv = (x @ w_qkv).reshape(bsz, seq, 3, B_HEADS, B_HEAD_DIM)
    q = jnp.moveaxis(qkv[:, :, 0], 1, 2)
    k = jnp.moveaxis(qkv[:, :, 1], 1, 2)
    v = jnp.moveaxis(qkv[:, :, 2], 1, 2)
    scale = B_HEAD_DIM ** -0.5
    outs = []
    for blk in range(seq // Q_BLOCK):
        q0 = blk * Q_BLOCK
        kend = q0 + Q_BLOCK
        qb = q[:, :, q0:kend].astype(jnp.float32)
        kb = k[:, :, :kend].astype(jnp.float32)
        vb = v[:, :, :kend]
        z = jnp.einsum('bhqd,bhkd->bhqk', qb, kb) * scale
        t_idx = q0 + jnp.arange(Q_BLOCK)[:, None]
        s_idx = jnp.arange(kend)[None, :]
        strict = s_idx < t_idx
        log_keep = jnp.where(strict, jax.nn.log_sigmoid(-z), 0.0)
        later = lax.cumsum(log_keep, axis=3, reverse=True) - log_keep
        log_a = jax.nn.log_sigmoid(z) + later
        a = jnp.where(strict, jnp.exp(log_a), 0.0)
        outs.append(jnp.einsum('bhqk,bhkd->bhqd', a.astype(vb.dtype), vb))
    o = jnp.concatenate(outs, axis=2)
    o = jnp.moveaxis(o, 1, 2).reshape(bsz, seq, B_HEADS * B_HEAD_DIM)
    return o @ w_o


def setup_inputs(seed: int = 0) -> dict:
    key = jax.random.key(seed)
    ks = jax.random.split(key, 16)
    f32 = jnp.float32

    def dense(k, shape, fan_in):
        return jax.random.normal(k, shape, f32) * (fan_in ** -0.5)

    x = jax.random.normal(ks[0], (BATCH, SEQ, D_MODEL), f32)
    norm_pre = 1.0 + 0.05 * jax.random.normal(ks[1], (DEPTH, 3, D_MODEL), f32)
    norm_post = 1.0 + 0.05 * jax.random.normal(ks[2], (DEPTH, 3, D_MODEL), f32)
    ffn_w_gate = dense(ks[3], (DEPTH, 2, D_MODEL, D_FF), D_MODEL)
    ffn_w_up = dense(ks[4], (DEPTH, 2, D_MODEL, D_FF), D_MODEL)
    ffn_w_down = dense(ks[5], (DEPTH, 2, D_FF, D_MODEL), D_FF)
    a_w_in = dense(ks[6], (N_A_LAYERS, D_MODEL, 2 * A_INNER), D_MODEL)
    a_ln_g = 1.0 + 0.05 * jax.random.normal(ks[7], (N_A_LAYERS, A_INNER), f32)
    a_w_s = dense(ks[8], (N_A_LAYERS, A_GROUPS, CHUNK, CHUNK), CHUNK)
    a_b_s = 1.0 + 0.1 * jax.random.normal(ks[9], (N_A_LAYERS, A_GROUPS, CHUNK), f32)
    a_w_out = dense(ks[10], (N_A_LAYERS, A_INNER, D_MODEL), A_INNER)
    b_w_qkv = dense(ks[11], (N_B_LAYERS, D_MODEL, 3 * D_MODEL), D_MODEL)
    b_w_o = dense(ks[12], (N_B_LAYERS, D_MODEL, D_MODEL), D_MODEL)
    return {"x": x, "norm_pre": norm_pre, "norm_post": norm_post,
            "ffn_w_gate": ffn_w_gate, "ffn_w_up": ffn_w_up, "ffn_w_down": ffn_w_down,
            "a_w_in": a_w_in, "a_ln_g": a_ln_g, "a_w_s": a_w_s, "a_b_s": a_b_s,
            "a_w_out": a_w_out, "b_w_qkv": b_w_qkv, "b_w_o": b_w_o}


def reference(x, norm_pre, norm_post, ffn_w_gate, ffn_w_up, ffn_w_down,
              a_w_in, a_ln_g, a_w_s, a_b_s, a_w_out, b_w_qkv, b_w_o):
    h = x
    for layer in range(DEPTH):
        f = swiglu(rms_norm(h, norm_pre[layer, 0]),
                   ffn_w_gate[layer, 0], ffn_w_up[layer, 0], ffn_w_down[layer, 0])
        h = h + 0.5 * rms_norm(f, norm_post[layer, 0])
        hn = rms_norm(h, norm_pre[layer, 1])
        if layer % N_MIXERS == 0:
            ia = layer // N_MIXERS
            m = chunked_gmlp(hn, a_w_in[ia], a_ln_g[ia], a_w_s[ia], a_b_s[ia], a_w_out[ia])
        else:
            ib = layer // N_MIXERS
            m = stick_breaking_attention(hn, b_w_qkv[ib], b_w_o[ib])
        h = h + rms_norm(m, norm_post[layer, 1])
        f = swiglu(rms_norm(h, norm_pre[layer, 2]),
                   ffn_w_gate[layer, 1], ffn_w_up[layer, 1], ffn_w_down[layer, 1])
        h = h + 0.5 * rms_norm(f, norm_post[layer, 2])
    return h
```

```cpp
#include <hip/hip_runtime.h>
#include <hip/hip_cooperative_groups.h>
#include <cstdio>
#include <cstdint>
namespace cg = cooperative_groups;
namespace pg8 {
#define PG8_LAS __attribute__((address_space(3)))
typedef unsigned short bf16_t;
typedef short bf16x8 __attribute__((ext_vector_type(8)));
typedef float f32x4 __attribute__((ext_vector_type(4)));
typedef unsigned u32x4 __attribute__((ext_vector_type(4)));
constexpr int BM = 256, BK = 64, HALF = 128, HTB = HALF * BK * 2  , STAGE_BYTES = 8 * HTB, NXCD = 8, WGM = 8;

__host__ __device__ __forceinline__ int lds_byte(int r, int c) { const int st = (r >> 4) * 2 + (c >> 5), rr = r & 15, cc = c & 31, ob = rr * 64 + cc * 2; return st * 1024 + (ob ^ (((ob >> 9) & 1) << 5)); }
__host__ __device__ __forceinline__ void stage_rc(int b, int& R, int& C) { const int st = b / 1024, sb = b % 1024, swz = sb ^ (((sb >> 9) & 1) << 5); R = (st >> 1) * 16 + swz / 64; C = (st & 1) * 32 + (swz % 64) / 2; }
__host__ __device__ __forceinline__ int perm32(int rho) { const int n = rho >> 4, i = rho & 15; return 8 * (i >> 2) + 4 * n + (i & 3); }

struct Unit { int pm, pn; };
struct Gemm { const bf16_t* A; const bf16_t* Bt; int M, N, K; };

struct StaticOrder {
    int nM, nN, nwg, G, c, i0 = 0, ni = 1 << 30;
    __host__ __device__ void init(int M, int N, int G_, int c_) { nM = M / BM; nN = N / BM; nwg = nM * nN; G = G_; c = c_; }
    __host__ __device__ bool next(int i, Unit& u) const {
        if (i >= ni) return false;
        const long L = (long)(i + i0) * G + c; if (L >= nwg) return false;
        int wgid = (int)L; { const int q = nwg / NXCD, r = nwg % NXCD, xcd = wgid % NXCD, off = wgid / NXCD; wgid = (xcd < r ? xcd * (q + 1) : r * (q + 1) + (xcd - r) * q) + off; }
        const int nig = WGM * nN, gid = wgid / nig, fm = gid * WGM, gsz = (nM - fm) < WGM ? (nM - fm) : WGM;
        u.pm = fm + ((wgid % nig) % gsz); u.pn = (wgid % nig) / gsz; return true;
    }
    __device__ __forceinline__ void a_ready(const Unit&) const {}
    __device__ __forceinline__ void done(const Unit&) const {}
};
__device__ __forceinline__ unsigned cvt_pk_bf16(float lo, float hi) { unsigned r; asm volatile("v_cvt_pk_bf16_f32 %0, %1, %2" : "=v"(r) : "v"(lo), "v"(hi)); return r; }
typedef float f32x2 __attribute__((ext_vector_type(2)));
__device__ __forceinline__ f32x2 gelu_pk(f32x2 v) {
    const f32x2 av = __builtin_elementwise_abs(v), d = av * 0.2316418882f + 1.0f;
    f32x2 t; t.x = __builtin_amdgcn_rcpf(d.x); t.y = __builtin_amdgcn_rcpf(d.y);
    f32x2 q = t * 0.5307027145f + (-0.7265760135f); q = q * t + 0.7107068705f; q = q * t + (-0.142248368f); q = q * t + 0.127414796f; q = q * t;
    const f32x2 s = (v * v) * (-0.72134752044f);
    f32x2 e; e.x = __builtin_amdgcn_exp2f(s.x); e.y = __builtin_amdgcn_exp2f(s.y);
    const f32x2 m = v * (q * e), r = v - m;
    f32x2 o; o.x = v.x < 0.f ? m.x : r.x; o.y = v.y < 0.f ? m.y : r.y; return o;
}
template <class Epi, class Sched, bool ALIGN_EPI = false, bool SP2 = false>
__device__ __forceinline__ void gemm_phase(PG8_LAS unsigned char* lds, const Gemm g, const Sched& S, const Epi& E) {
    int tid_ = threadIdx.x; asm volatile("" : "+v"(tid_));
    const int tid = tid_, wid = __builtin_amdgcn_readfirstlane(tid >> 6), lane = tid & 63, wr = wid >> 2, wc = wid & 3, fr = lane & 15, fq = lane >> 4;
    const int K = g.K, nt = K / BK;
    unsigned voffA[2], voffB[2];
#pragma unroll
    for (int i = 0; i < 2; ++i) { int R, C; stage_rc(tid * 16 + i * 8192, R, C); const int Rb = Epi::PERM ? ((R & ~31) + perm32(R & 31)) : R;
        voffA[i] = (unsigned)(R * K + C) * 2u; voffB[i] = (unsigned)(Rb * K + C) * 2u; }
    const size_t kstep = (size_t)(BK * 2);
    const size_t hstep = (size_t)HALF * K * 2;
    const size_t tstep = 2 * hstep;
    const unsigned ldsw = (unsigned)wid * 1024u;
    const int aoff = lds_byte(wr * 64 + fr, fq * 8), boff = lds_byte(wc * 32 + fr, fq * 8);
#define PG8_SA(b, h) (((b) * 2 + (h)) * HTB)
#define PG8_SB(b, h) ((4 + (b) * 2 + (h)) * HTB)
#define PG8_STAGE(bufoff, gbase, voff) do { _Pragma("unroll") for (int _i = 0; _i < 2; ++_i) \
        __builtin_amdgcn_global_load_lds((const unsigned*)((const char*)(gbase) + (voff)[_i]), (PG8_LAS unsigned*)(lds + (bufoff) + ldsw + _i * 8192), 16, 0, 0); } while (0)
#define PG8_LDA(dst, b, h) do { _Pragma("unroll") for (int m = 0; m < 4; ++m) _Pragma("unroll") for (int k = 0; k < 2; ++k) dst[m][k] = *(const PG8_LAS bf16x8*)(lds + PG8_SA(b, h) + aoff + m * 2048 + k * 1024); } while (0)
#define PG8_LDB(dst, b, h) do { _Pragma("unroll") for (int n = 0; n < 2; ++n) _Pragma("unroll") for (int k = 0; k < 2; ++k) dst[n][k] = *(const PG8_LAS bf16x8*)(lds + PG8_SB(b, h) + boff + n * 2048 + k * 1024); } while (0)
#define PG8_MMA(ai, bj, At, Bt) do { __builtin_amdgcn_s_setprio(1); _Pragma("unroll") for (int m = 0; m < 4; ++m) _Pragma("unroll") for (int n = 0; n < 2; ++n) _Pragma("unroll") for (int k = 0; k < 2; ++k) \
        acc[ai][bj][m][n] = __builtin_amdgcn_mfma_f32_16x16x32_bf16(Bt[n][k], At[m][k], acc[ai][bj][m][n], 0, 0, 0); __builtin_amdgcn_s_setprio(0); } while (0)
#define PG8_WAIT_V(n) asm volatile("s_waitcnt vmcnt(" #n ")" ::: "memory")
#define PG8_WAIT_L(n) asm volatile("s_waitcnt lgkmcnt(" #n ")" ::: "memory")
#define PG8_BAR __builtin_amdgcn_s_barrier()
#define PG8_SCHED __builtin_amdgcn_sched_barrier(0)
    Unit cur, nxt; int ui = 0;
    if (!S.next(0, cur)) return;
    f32x4 acc[2][2][4][2];
#pragma unroll
    for (int a = 0; a < 2; ++a)
#pragma unroll
        for (int b = 0; b < 2; ++b)
#pragma unroll
            for (int m = 0; m < 4; ++m)
#pragma unroll
                for (int n = 0; n < 2; ++n) acc[a][b][m][n] = (f32x4){0.f, 0.f, 0.f, 0.f};
    bf16x8 At[4][2], B0[2][2], B1[2][2];
    const char* cA = (const char*)g.A + (size_t)cur.pm * tstep; const char* cB = (const char*)g.Bt + (size_t)cur.pn * tstep;
    S.a_ready(cur);
    float epre[8];
    if constexpr (Epi::PREFETCH) E.prefetch(cur, wr, fr, epre);
    if constexpr (SP2) {
        PG8_STAGE(PG8_SB(0, 0), cB, voffB); PG8_STAGE(PG8_SB(0, 1), cB + hstep, voffB); PG8_STAGE(PG8_SA(0, 0), cA, voffA); PG8_STAGE(PG8_SA(0, 1), cA + hstep, voffA);
        if (wr == 1) PG8_BAR;
        PG8_WAIT_V(2); PG8_BAR;
        PG8_STAGE(PG8_SB(1, 0), cB + kstep, voffB); PG8_STAGE(PG8_SA(1, 0), cA + kstep, voffA); PG8_STAGE(PG8_SB(1, 1), cB + hstep + kstep, voffB);
        PG8_WAIT_V(6); PG8_BAR;
    } else {
        PG8_STAGE(PG8_SB(0, 0), cB, voffB); PG8_STAGE(PG8_SA(0, 0), cA, voffA); PG8_STAGE(PG8_SB(0, 1), cB + hstep, voffB); PG8_STAGE(PG8_SA(0, 1), cA + hstep, voffA);
        if (wr == 1) PG8_BAR;
        PG8_WAIT_V(4); PG8_BAR;
        PG8_STAGE(PG8_SB(1, 0), cB + kstep, voffB); PG8_STAGE(PG8_SA(1, 0), cA + kstep, voffA); PG8_STAGE(PG8_SB(1, 1), cB + hstep + kstep, voffB);
        PG8_WAIT_V(6); PG8_BAR;
    }
    for (;;) {
        const bool has_next = S.next(ui + 1, nxt);
        const char* nA = has_next ? (const char*)g.A + (size_t)nxt.pm * tstep : cA; const char* nB = has_next ? (const char*)g.Bt + (size_t)nxt.pn * tstep : cB;
        for (int t = 0; t < nt; t += 2) {
            const bool last = (t == nt - 2);
            const char* a1 = cA + (size_t)(t + 1) * kstep;
            const char* a2 = last ? nA : cA + (size_t)(t + 2) * kstep; const char* b2 = last ? nB : cB + (size_t)(t + 2) * kstep;
            const char* a3 = a2 + kstep; const char* b3 = b2 + kstep;
            if (last && has_next) S.a_ready(nxt);
            if constexpr (SP2) {
            PG8_LDB(B0, 0, 0); PG8_LDB(B1, 0, 1); PG8_SCHED; PG8_LDA(At, 0, 0); PG8_STAGE(PG8_SA(1, 1), a1 + hstep, voffA);
            PG8_WAIT_V(8); PG8_WAIT_L(0); PG8_BAR; PG8_MMA(0, 0, At, B0); PG8_MMA(0, 1, At, B1); PG8_BAR; PG8_SCHED;
            PG8_LDA(At, 0, 1); PG8_STAGE(PG8_SB(0, 0), b2, voffB); PG8_STAGE(PG8_SB(0, 1), b2 + hstep, voffB); PG8_STAGE(PG8_SA(0, 0), a2, voffA);
            PG8_WAIT_V(8); PG8_WAIT_L(0); PG8_BAR; PG8_MMA(1, 0, At, B0); PG8_MMA(1, 1, At, B1); PG8_BAR; PG8_SCHED;
            PG8_LDB(B0, 1, 0); PG8_LDB(B1, 1, 1); PG8_SCHED; PG8_LDA(At, 1, 0); PG8_STAGE(PG8_SA(0, 1), a2 + hstep, voffA);
            PG8_WAIT_V(8); PG8_WAIT_L(0); PG8_BAR; PG8_MMA(0, 0, At, B0); PG8_MMA(0, 1, At, B1); PG8_BAR; PG8_SCHED;
            PG8_LDA(At, 1, 1); PG8_STAGE(PG8_SB(1, 0), b3, voffB); PG8_STAGE(PG8_SB(1, 1), b3 + hstep, voffB); PG8_STAGE(PG8_SA(1, 0), a3, voffA);
            PG8_WAIT_V(8); PG8_WAIT_L(0); PG8_BAR; PG8_MMA(1, 0, At, B0); PG8_MMA(1, 1, At, B1); PG8_BAR; PG8_SCHED;
            } else {
            PG8_LDB(B0, 0, 0); PG8_SCHED; PG8_LDA(At, 0, 0); PG8_STAGE(PG8_SA(1, 1), a1 + hstep, voffA);
            PG8_WAIT_L(8); PG8_BAR; PG8_WAIT_L(0); PG8_MMA(0, 0, At, B0); PG8_BAR; PG8_SCHED;
            PG8_LDB(B1, 0, 1); PG8_STAGE(PG8_SB(0, 0), b2, voffB);
            PG8_BAR; PG8_WAIT_L(0); PG8_MMA(0, 1, At, B1); PG8_BAR;
            PG8_LDA(At, 0, 1); PG8_STAGE(PG8_SA(0, 0), a2, voffA);
            PG8_BAR; PG8_WAIT_L(0); PG8_MMA(1, 0, At, B0); PG8_BAR; PG8_SCHED;
            PG8_STAGE(PG8_SB(0, 1), b2 + hstep, voffB);
            PG8_WAIT_V(6); PG8_BAR; PG8_MMA(1, 1, At, B1); PG8_BAR;
            PG8_LDB(B0, 1, 0); PG8_SCHED; PG8_LDA(At, 1, 0); PG8_STAGE(PG8_SA(0, 1), a2 + hstep, voffA);
            PG8_WAIT_L(8); PG8_BAR; PG8_WAIT_L(0); PG8_MMA(0, 0, At, B0); PG8_BAR; PG8_SCHED;
            PG8_LDB(B1, 1, 1); PG8_STAGE(PG8_SB(1, 0), b3, voffB);
            PG8_BAR; PG8_WAIT_L(0); PG8_MMA(0, 1, At, B1); PG8_BAR;
            PG8_LDA(At, 1, 1); PG8_STAGE(PG8_SA(1, 0), a3, voffA);
            PG8_BAR; PG8_WAIT_L(0); PG8_MMA(1, 0, At, B0); PG8_BAR; PG8_SCHED;
            PG8_STAGE(PG8_SB(1, 1), b3 + hstep, voffB);
            PG8_WAIT_V(6); PG8_BAR; PG8_MMA(1, 1, At, B1); PG8_BAR;
            }
        }
        if constexpr (ALIGN_EPI) { if (wr == 0) PG8_BAR; }
        if constexpr (!Epi::AFTER_DRAIN) { if constexpr (Epi::PREFETCH) E(acc, cur, wr, wc, fr, fq, epre); else E(acc, cur, wr, wc, fr, fq); S.done(cur); }
        if (!has_next) break;
#pragma unroll
        for (int a = 0; a < 2; ++a)
#pragma unroll
            for (int b = 0; b < 2; ++b)
#pragma unroll
                for (int m = 0; m < 4; ++m)
#pragma unroll
                    for (int n = 0; n < 2; ++n) acc[a][b][m][n] = (f32x4){0.f, 0.f, 0.f, 0.f};
        cur = nxt; cA = nA; cB = nB; ++ui;
        if constexpr (Epi::PREFETCH) E.prefetch(cur, wr, fr, epre);
        if constexpr (ALIGN_EPI) { if (wr == 1) PG8_BAR; }
    }
    PG8_WAIT_V(0);
    if constexpr (!ALIGN_EPI) { if (wr == 0) PG8_BAR; }
    PG8_BAR;
    if constexpr (Epi::AFTER_DRAIN) { E.fused(acc, cur, wr, wc, fr, fq, lds, wid, lane); S.done(cur); }
#undef PG8_SA
#undef PG8_SB
#undef PG8_STAGE
#undef PG8_LDA
#undef PG8_LDB
#undef PG8_MMA
#undef PG8_WAIT_V
#undef PG8_WAIT_L
#undef PG8_BAR
#undef PG8_SCHED
}
}
#define LAS __attribute__((address_space(3)))
#define GAS __attribute__((address_space(1)))
using pg8::bf16_t; using pg8::f32x4; using pg8::u32x4; using pg8::bf16x8; using pg8::Unit; using pg8::cvt_pk_bf16; using pg8::f32x2; using pg8::gelu_pk;
typedef float f32x16 __attribute__((ext_vector_type(16)));
typedef unsigned u32x2 __attribute__((ext_vector_type(2)));

constexpr int TOK = 65536, DM = 1024, DFF = 2816, SEQ = 2048, NB = 32, NH = 16, DEPTH = 4;
constexpr float RMS_EPS = 1e-6f, LN_EPS = 1e-5f;
constexpr float QSCALE = 0.125f * 1.4426950408889634f;
constexpr int NTHREADS = 512, NWAVES = 8;
constexpr int LDS_BYTES = 132096;

constexpr size_t MiB = 1u << 20;
constexpr size_t WS_BAR = 0, BAR_BYTES = 32768;
constexpr size_t WS_SS = 1 * MiB, WS_VSUM = 5 * MiB, WS_VSQ = 7 * MiB;
constexpr size_t WS_W = 10 * MiB;
constexpr size_t WS_RS = 9 * MiB;
constexpr size_t WS_HN = 170 * MiB, WS_F = 298 * MiB, WS_BIG = 426 * MiB, WS_LO = 810 * MiB, WS_END = 874 * MiB;
static_assert(WS_W + 160 * MiB <= WS_HN, "ws map");
constexpr size_t W_FFN_STRIDE = (size_t)3 * DM * DFF, W_GU = 0, W_DN = (size_t)2 * DM * DFF;
constexpr size_t W_A0 = 8 * W_FFN_STRIDE, W_A_STRIDE = (size_t)3 * DM * DM, W_AIN = 0, W_AOUT = (size_t)2 * DM * DM;
constexpr size_t W_B0 = W_A0 + 2 * W_A_STRIDE, W_B_STRIDE = (size_t)4 * DM * DM, W_BQKV = 0, W_BO = (size_t)3 * DM * DM;
static_assert((W_B0 + 2 * W_B_STRIDE) * 2 == 160 * MiB, "weight map");

__device__ __forceinline__ float silu_mul(float g, float u) { const float e = __builtin_amdgcn_exp2f(-1.4426950408889634f * g); return g * __builtin_amdgcn_rcpf(1.0f + e) * u; }
struct EpiSwiGLU {
    static constexpr bool PERM = true, AFTER_DRAIN = false, PREFETCH = true; bf16_t* O; const float* rs;
    __device__ __forceinline__ void prefetch(const Unit& u, int wr, int fr, float (&pre)[8]) const {
#pragma unroll
        for (int i = 0; i < 8; ++i) pre[i] = *(const GAS float*)(rs + u.pm * 256 + wr * 64 + fr + (i >> 2) * 128 + (i & 3) * 16);
    }
    __device__ __forceinline__ void operator()(const f32x4 (&acc)[2][2][4][2], const Unit& u, int wr, int wc, int fr, int fq, const float (&pre)[8]) const {
        const int row0 = u.pm * 256 + wr * 64 + fr, col0 = u.pn * 128 + wc * 32 + 8 * fq;
#pragma unroll
        for (int ai = 0; ai < 2; ++ai)
#pragma unroll
            for (int m = 0; m < 4; ++m) {
                const float rsc = pre[ai * 4 + m];
                const f32x4 g0 = acc[ai][0][m][0] * rsc, g1 = acc[ai][0][m][1] * rsc, u0 = acc[ai][1][m][0] * rsc, u1 = acc[ai][1][m][1] * rsc;
                u32x4 w; w.x = cvt_pk_bf16(silu_mul(g0[0], u0[0]), silu_mul(g0[1], u0[1])); w.y = cvt_pk_bf16(silu_mul(g0[2], u0[2]), silu_mul(g0[3], u0[3]));
                w.z = cvt_pk_bf16(silu_mul(g1[0], u1[0]), silu_mul(g1[1], u1[1])); w.w = cvt_pk_bf16(silu_mul(g1[2], u1[2]), silu_mul(g1[3], u1[3]));
                *(GAS u32x4*)(O + (size_t)(row0 + ai * 128 + m * 16) * DFF + col0) = w; }
    }
};
template <int ACT, int STAT, int RS  > struct EpiStore {
    static constexpr bool PERM = true, AFTER_DRAIN = false, PREFETCH = (RS == 1); bf16_t* O; int ldc; int nsc; float scale; float* s1; float* s2; const float* rs;
    __device__ __forceinline__ void prefetch(const Unit& u, int wr, int fr, float (&pre)[8]) const {
#pragma unroll
        for (int i = 0; i < 8; ++i) pre[i] = *(const GAS float*)(rs + u.pm * 256 + wr * 64 + fr + (i >> 2) * 128 + (i & 3) * 16);
    }
    __device__ __forceinline__ void operator()(const f32x4 (&acc)[2][2][4][2], const Unit& u, int wr, int wc, int fr, int fq) const { const float none[8] = {1.f, 1.f, 1.f, 1.f, 1.f, 1.f, 1.f, 1.f}; (*this)(acc, u, wr, wc, fr, fq, none); }
    __device__ __forceinline__ void operator()(const f32x4 (&acc)[2][2][4][2], const Unit& u, int wr, int wc, int fr, int fq, const float (&pre)[8]) const {
        const int row0 = u.pm * 256 + wr * 64 + fr, col0 = u.pn * 256 + wc * 32 + 8 * fq;
        const float sc = (u.pn < nsc) ? scale : 1.f;
        float cs[2][2][4], cq[2][2][4];
#pragma unroll
        for (int a = 0; a < 2; ++a)
#pragma unroll
            for (int b = 0; b < 2; ++b)
#pragma unroll
                for (int e = 0; e < 4; ++e) { cs[a][b][e] = 0.f; cq[a][b][e] = 0.f; }
        f32x4 csc[2][2];
        if (RS == 2) {
#pragma unroll
            for (int bj = 0; bj < 2; ++bj) { csc[bj][0] = *(const GAS f32x4*)(rs + col0 + bj * 128); csc[bj][1] = *(const GAS f32x4*)(rs + col0 + bj * 128 + 4); }
        }
#pragma unroll
        for (int ai = 0; ai < 2; ++ai)
#pragma unroll
            for (int m = 0; m < 4; ++m) {
                const int row = row0 + ai * 128 + m * 16; bf16_t* rowp = O + (size_t)row * ldc + col0; float rs = 0.f;
                float rsc = 1.f; if (RS == 1) rsc = pre[ai * 4 + m];
#pragma unroll
                for (int bj = 0; bj < 2; ++bj) {
                    f32x4 v0 = acc[ai][bj][m][0], v1 = acc[ai][bj][m][1];
                    if (RS == 1) { v0 = v0 * rsc; v1 = v1 * rsc; }
                    if (RS == 2) { v0 = v0 * csc[bj][0]; v1 = v1 * csc[bj][1]; }
                    if (ACT == 1) { const f32x2 a = gelu_pk((f32x2){v0[0], v0[1]}), b = gelu_pk((f32x2){v0[2], v0[3]}), c = gelu_pk((f32x2){v1[0], v1[1]}), d = gelu_pk((f32x2){v1[2], v1[3]});
                        v0 = (f32x4){a.x, a.y, b.x, b.y}; v1 = (f32x4){c.x, c.y, d.x, d.y}; }
                    v0 = v0 * sc; v1 = v1 * sc;
                    if (STAT == 1) rs += (v0[0] * v0[0] + v0[1] * v0[1]) + (v0[2] * v0[2] + v0[3] * v0[3]) + (v1[0] * v1[0] + v1[1] * v1[1]) + (v1[2] * v1[2] + v1[3] * v1[3]);
                    if (STAT == 2) {
#pragma unroll
                        for (int e = 0; e < 4; ++e) { cs[bj][0][e] += v0[e]; cq[bj][0][e] += v0[e] * v0[e]; cs[bj][1][e] += v1[e]; cq[bj][1][e] += v1[e] * v1[e]; } }
                    u32x4 w; w.x = cvt_pk_bf16(v0[0], v0[1]); w.y = cvt_pk_bf16(v0[2], v0[3]); w.z = cvt_pk_bf16(v1[0], v1[1]); w.w = cvt_pk_bf16(v1[2], v1[3]);
                    *(GAS u32x4*)(rowp + bj * 128) = w; }
                if (STAT == 1) { rs += __shfl_xor(rs, 16); rs += __shfl_xor(rs, 32); if (fq == 0) *(GAS float*)(s1 + (size_t)row * 16 + u.pn * 4 + wc) = rs; }
            }
        if (STAT == 2) {
#pragma unroll
            for (int bj = 0; bj < 2; ++bj)
#pragma unroll
                for (int n = 0; n < 2; ++n)
#pragma unroll
                    for (int e = 0; e < 4; ++e) { float a = cs[bj][n][e], b = cq[bj][n][e];
#pragma unroll
                        for (int o = 1; o < 16; o <<= 1) { a += __shfl_xor(a, o); b += __shfl_xor(b, o); }
                        if (fr == 0) { const size_t slot = (size_t)(col0 + bj * 128 + 4 * n + e) * 8 + u.pm * 2 + wr; *(GAS float*)(s1 + slot) = a; *(GAS float*)(s2 + slot) = b; } }
        }
    }
};

#define LDS_WAIT() asm volatile("s_waitcnt lgkmcnt(0)" ::: "memory")
__device__ __forceinline__ float wave_sum(float v) {
#pragma unroll
    for (int o = 1; o < 64; o <<= 1) v += __shfl_xor(v, o);
    return v;
}
__device__ __forceinline__ float bf_lo(unsigned w) { return __uint_as_float(w << 16); }
__device__ __forceinline__ float bf_hi(unsigned w) { return __uint_as_float(w & 0xffff0000u); }

struct WItem { const float* W; const float* gk; bf16_t* WT; int K, N, drow0, k0, n0; };
__device__ __forceinline__ void item_load(const WItem& I, float (&v)[32], int lane) {
#pragma unroll
    for (int i = 0; i < 32; ++i) { const int kk = 2 * i + (lane >> 5); const float g = I.gk ? I.gk[I.k0 + kk] : 1.0f; v[i] = g * __builtin_nontemporal_load(I.W + (size_t)(I.k0 + kk) * I.N + I.n0 + (lane & 31)); }
}
__device__ __forceinline__ void item_store(const WItem& I, const float (&v)[32], LAS float* scr, int lane) {
#pragma unroll
    for (int i = 0; i < 32; ++i) { const int kk = 2 * i + (lane >> 5); scr[kk * 33 + (lane & 31)] = v[i]; }
    LDS_WAIT(); asm volatile("" ::: "memory");
    const int c = lane & 7;
#pragma unroll
    for (int j = 0; j < 4; ++j) { const int n = (lane >> 3) + 8 * j; const LAS float* s = scr + (8 * c) * 33 + n;
        u32x4 o; o.x = cvt_pk_bf16(s[0 * 33], s[1 * 33]); o.y = cvt_pk_bf16(s[2 * 33], s[3 * 33]); o.z = cvt_pk_bf16(s[4 * 33], s[5 * 33]); o.w = cvt_pk_bf16(s[6 * 33], s[7 * 33]);
        *(GAS u32x4*)(I.WT + (size_t)(I.drow0 + n) * I.K + I.k0 + 8 * c) = o; }
    LDS_WAIT(); asm volatile("" ::: "memory");
}

struct Ptrs {
    const float *x, *norm_pre, *norm_post, *wg, *wu, *wd, *a_win, *a_lng, *a_ws, *a_bs, *a_wout, *b_wqkv, *b_wo;
    float* out; unsigned char* ws;
};

__device__ __forceinline__ float lo_decode(unsigned hi16, int q4) { return __uint_as_float((hi16 << 16) + (unsigned)(q4 << 12)); }
__device__ __forceinline__ unsigned lo_encode(float h, unsigned hi16) {
    int d = (int)(__float_as_uint(h) - (hi16 << 16)); d = (d + 2048) >> 12; d = d > 7 ? 7 : d;
    return (unsigned)d & 0xfu;
}
struct FinStage { f32x4 v[2][2][2]; u32x4 hw[2][2]; unsigned lw[2][2]; u32x4 fw[2][2]; float sp[2]; };
template <bool HIN_F32>
__device__ __forceinline__ void fin_load(FinStage& S, const float* x, const bf16_t* HI, const unsigned char* LO, const bf16_t* f, const float* ss, int row0, int NGW, int lane) {
#pragma unroll
    for (int t = 0; t < 2; ++t) { const int row = row0 + t * NGW;
#pragma unroll
        for (int j = 0; j < 2; ++j) { const int idx = 512 * j + 8 * lane;
            if (HIN_F32) { S.v[t][j][0] = *(const GAS f32x4*)(x + (size_t)row * DM + idx); S.v[t][j][1] = *(const GAS f32x4*)(x + (size_t)row * DM + idx + 4); }
            else { S.hw[t][j] = __builtin_nontemporal_load((const GAS u32x4*)(HI + (size_t)row * DM + idx)); S.lw[t][j] = __builtin_nontemporal_load((const GAS unsigned*)(LO + (size_t)row * (DM / 2) + (idx >> 1))); }
            S.fw[t][j] = __builtin_nontemporal_load((const GAS u32x4*)(f + (size_t)row * DM + idx)); }
        S.sp[t] = *(const GAS float*)(ss + (size_t)row * 16 + (lane & 15)); }
}
template <bool HIN_F32, bool LAST>
__device__ __forceinline__ void fin_compute(FinStage& S, float* out, bf16_t* HI, unsigned char* LO, float* rs, const f32x4 (&gpv)[4], float coef, int row0, int NGW, int lane) {
#pragma unroll
    for (int t = 0; t < 2; ++t) { const int row = row0 + t * NGW; float s2 = 0.f;
        float tot = S.sp[t];
#pragma unroll
        for (int o = 1; o < 16; o <<= 1) tot += __shfl_xor(tot, o);
        const float r = coef * __builtin_amdgcn_rsqf(tot * (1.0f / DM) + RMS_EPS);
#pragma unroll
        for (int j = 0; j < 2; ++j) { const int idx = 512 * j + 8 * lane; float v[8];
            const u32x4 fw = S.fw[t][j];
            if (HIN_F32) {
#pragma unroll
                for (int e = 0; e < 8; ++e) v[e] = S.v[t][j][e >> 2][e & 3];
            } else { const u32x4 hw = S.hw[t][j]; const unsigned lw = S.lw[t][j];
#pragma unroll
                for (int e = 0; e < 8; ++e) { const unsigned w = hw[e >> 1]; v[e] = lo_decode((e & 1) ? (w >> 16) : (w & 0xffffu), (int)(lw << (28 - 4 * e)) >> 28); } }
#pragma unroll
            for (int e = 0; e < 8; ++e) { const unsigned w = fw[e >> 1]; v[e] += ((e & 1) ? bf_hi(w) : bf_lo(w)) * r * gpv[2 * j + (e >> 2)][e & 3]; }
            if (LAST) { *(GAS f32x4*)(out + (size_t)row * DM + idx) = (f32x4){v[0], v[1], v[2], v[3]}; *(GAS f32x4*)(out + (size_t)row * DM + idx + 4) = (f32x4){v[4], v[5], v[6], v[7]}; }
            else { u32x4 hw; hw.x = cvt_pk_bf16(v[0], v[1]); hw.y = cvt_pk_bf16(v[2], v[3]); hw.z = cvt_pk_bf16(v[4], v[5]); hw.w = cvt_pk_bf16(v[6], v[7]);
                unsigned lw = 0u;
#pragma unroll
                for (int e = 0; e < 8; ++e) { const unsigned w = hw[e >> 1]; lw |= lo_encode(v[e], (e & 1) ? (w >> 16) : (w & 0xffffu)) << (4 * e); s2 += v[e] * v[e]; }
                *(GAS u32x4*)(HI + (size_t)row * DM + idx) = hw; __builtin_nontemporal_store(lw, (GAS unsigned*)(LO + (size_t)row * (DM / 2) + (idx >> 1))); } }
        if (!LAST) { const float rn = __builtin_amdgcn_rsqf(wave_sum(s2) * (1.0f / DM) + RMS_EPS); if (lane == 0) *(GAS float*)(rs + row) = rn; } }
}
template <bool HIN_F32, bool LAST>
__device__ __forceinline__ void fin_phase(const float* x, float* out, bf16_t* HI, unsigned char* LO, float* rs, const bf16_t* f, const float* ss, const float* gpost, float coef, int gw, int NGW, int rend, int lane) {
    f32x4 gpv[4];
#pragma unroll
    for (int j = 0; j < 4; ++j) gpv[j] = *(const GAS f32x4*)(gpost + 512 * (j >> 1) + 8 * lane + 4 * (j & 1));
    constexpr int NS = HIN_F32 ? 2 : 3;
    FinStage S[NS];
#pragma unroll
    for (int u = 0; u < NS - 1; ++u) if (gw + 2 * NGW * u < rend) fin_load<HIN_F32>(S[u], x, HI, LO, f, ss, gw + 2 * NGW * u, NGW, lane);
    for (int base = gw; base < rend; base += 2 * NS * NGW) {
#pragma unroll
        for (int u = 0; u < NS; ++u) {
            const int rowc = base + 2 * NGW * u, rowl = rowc + 2 * NGW * (NS - 1);
            if (rowl < rend) fin_load<HIN_F32>(S[(u + NS - 1) % NS], x, HI, LO, f, ss, rowl, NGW, lane);
            if (rowc < rend) fin_compute<HIN_F32, LAST>(S[u], out, HI, LO, rs, gpv, coef, rowc, NGW, lane);
        }
    }
}
__device__ __forceinline__ void x_phase(const float* x, bf16_t* HI, float* rs, int gw, int NGW, int lane) {
    for (int row0 = gw; row0 < TOK; row0 += 4 * NGW) {
        f32x4 v[4][4];
#pragma unroll
        for (int t = 0; t < 4; ++t) { const int row = row0 + t * NGW;
#pragma unroll
            for (int j = 0; j < 4; ++j) v[t][j] = (row < TOK) ? __builtin_nontemporal_load((const GAS f32x4*)(x + (size_t)row * DM + 256 * j + 4 * lane)) : (f32x4){0.f, 0.f, 0.f, 0.f}; }
#pragma unroll
        for (int t = 0; t < 4; ++t) { const int row = row0 + t * NGW; float s2 = 0.f;
            if (row < TOK) {
#pragma unroll
                for (int j = 0; j < 4; ++j) { s2 += (v[t][j][0] * v[t][j][0] + v[t][j][1] * v[t][j][1]) + (v[t][j][2] * v[t][j][2] + v[t][j][3] * v[t][j][3]);
                    u32x2 hw; hw.x = cvt_pk_bf16(v[t][j][0], v[t][j][1]); hw.y = cvt_pk_bf16(v[t][j][2], v[t][j][3]); *(GAS u32x2*)(HI + (size_t)row * DM + 256 * j + 4 * lane) = hw; }
                const float rn = __builtin_amdgcn_rsqf(wave_sum(s2) * (1.0f / DM) + RMS_EPS); if (lane == 0) *(GAS float*)(rs + row) = rn; } }
    }
}
__device__ __forceinline__ WItem witem(const Ptrs& P, int it) {
    bf16_t* WB = (bf16_t*)(P.ws + WS_W);
    constexpr int I_FFN = (DM / 64) * (DFF / 32);
    constexpr int N_FFN = 8 * 3 * I_FFN;
    constexpr int I_AIN = 16 * 64, I_AOUT = 16 * 32, N_A = 2 * (I_AIN + I_AOUT);
    constexpr int I_BQKV = 16 * 96, I_BO = 16 * 32;
    WItem I; I.gk = nullptr;
    if (it < N_FFN) {
        const int q = it / I_FFN, r = it % I_FFN, li = q / 3, which = q % 3;
        bf16_t* base = WB + (size_t)li * W_FFN_STRIDE;
        if (which < 2) {
            const int nblk = DFF / 32, kb = r / nblk, nb = r % nblk, n0 = 32 * nb;
            I.W = (which == 0 ? P.wg : P.wu) + (size_t)li * DM * DFF; I.K = DM; I.N = DFF; I.WT = base + W_GU; I.drow0 = 256 * (n0 >> 7) + 128 * which + (n0 & 127); I.k0 = 64 * kb; I.n0 = n0;
            I.gk = P.norm_pre + (size_t)((li >> 1) * 3 + (li & 1) * 2) * DM;
        } else {
            const int nblk = DM / 32, kb = r / nblk, nb = r % nblk, n0 = 32 * nb;
            I.W = P.wd + (size_t)li * DFF * DM; I.K = DFF; I.N = DM; I.WT = base + W_DN; I.drow0 = n0; I.k0 = 64 * kb; I.n0 = n0;
        }
    } else if (it < N_FFN + N_A) {
        const int i2 = it - N_FFN, la = i2 / (I_AIN + I_AOUT), r = i2 % (I_AIN + I_AOUT);
        bf16_t* base = WB + W_A0 + (size_t)la * W_A_STRIDE;
        if (r < I_AIN) { const int nblk = 64, kb = r / nblk, nb = r % nblk; I.W = P.a_win + (size_t)la * DM * 2 * DM; I.K = DM; I.N = 2 * DM; I.WT = base + W_AIN; I.drow0 = 32 * nb; I.k0 = 64 * kb; I.n0 = 32 * nb; I.gk = P.norm_pre + (size_t)((2 * la) * 3 + 1) * DM; }
        else { const int r2 = r - I_AIN, nblk = 32, kb = r2 / nblk, nb = r2 % nblk; I.W = P.a_wout + (size_t)la * DM * DM; I.K = DM; I.N = DM; I.WT = base + W_AOUT; I.drow0 = 32 * nb; I.k0 = 64 * kb; I.n0 = 32 * nb; }
    } else {
        const int i3 = it - N_FFN - N_A, lb = i3 / (I_BQKV + I_BO), r = i3 % (I_BQKV + I_BO);
        bf16_t* base = WB + W_B0 + (size_t)lb * W_B_STRIDE;
        if (r < I_BQKV) { const int nblk = 96, kb = r / nblk, nb = r % nblk; I.W = P.b_wqkv + (size_t)lb * DM * 3 * DM; I.K = DM; I.N = 3 * DM; I.WT = base + W_BQKV; I.drow0 = 32 * nb; I.k0 = 64 * kb; I.n0 = 32 * nb; I.gk = P.norm_pre + (size_t)((2 * lb + 1) * 3 + 1) * DM; }
        else { const int r2 = r - I_BQKV, nblk = 32, kb = r2 / nblk, nb = r2 % nblk; I.W = P.b_wo + (size_t)lb * DM * DM; I.K = DM; I.N = DM; I.WT = base + W_BO; I.drow0 = 32 * nb; I.k0 = 64 * kb; I.n0 = 32 * nb; }
    }
    return I;
}
__device__ __forceinline__ void prologue_phase(const Ptrs& P, LAS unsigned char* lds, int gw, int NGW, int wave, int lane) {
    LAS float* scr = (LAS float*)(lds + wave * 16384);
    constexpr int NITEMS = 8 * 3 * ((DM / 64) * (DFF / 32)) + 2 * (16 * 64 + 16 * 32) + 2 * (16 * 96 + 16 * 32);
    float va[32], vb[32];
    if (gw < NITEMS) { WItem Ia = witem(P, gw); item_load(Ia, va, lane);
        for (int it = gw; it < NITEMS; it += 2 * NGW) {
            const int i1 = it + NGW, i2 = it + 2 * NGW; WItem Ib = Ia;
            if (i1 < NITEMS) { Ib = witem(P, i1); item_load(Ib, vb, lane); }
            item_store(Ia, va, scr, lane);
            if (i1 < NITEMS) { if (i2 < NITEMS) { Ia = witem(P, i2); item_load(Ia, va, lane); }
                item_store(Ib, vb, scr, lane); }
        } }
    x_phase(P.x, (bf16_t*)(P.ws + WS_HN), (float*)(P.ws + WS_RS), gw, NGW, lane);
}

__device__ __forceinline__ int rowmap32(int m) { return 16 * ((m >> 2) & 1) + 4 * (m >> 3) + (m & 3); }
__device__ __forceinline__ bf16x8 lds_frag(const LAS unsigned char* p) { return *(const LAS bf16x8*)p; }

__device__ __forceinline__ void spatial_phase(LAS unsigned char* lds, const bf16_t* U, const bf16_t* VT, const float* vsum, const float* vsq, const float* lng, const float* Ws, const float* bs, bf16_t* Y, int c0, int G, int nunits, int ldt) {
    int tid_ = threadIdx.x; asm volatile("" : "+v"(tid_));
    const int tid = tid_, lane = tid & 63, wid = __builtin_amdgcn_readfirstlane(tid >> 6), q = lane & 31, hh = lane >> 5;
    LAS unsigned char* Wl = lds; LAS unsigned char* Vl = lds + 32768; LAS float* st = (LAS float*)(lds + 98304);
    const bool wfixed = (G & 7) == 0;
    const int r4 = tid >> 2, sbase = (tid & 3) * 32, vswz = (r4 & 7) | (((r4 >> 4) & 1) << 3);
    const int ct = wid & 3, tp = wid >> 2, arow = ct * 32 + rowmap32(q), aswz = (arow & 7) | (((arow >> 4) & 1) << 3);
#define SP_STATS(unit_, buf_) do { if (tid < 128) { const int tok_ = ((unit_) >> 3) * 128 + tid; const GAS f32x4* p1 = (const GAS f32x4*)(vsum + (size_t)tok_ * 8); const GAS f32x4* p2 = (const GAS f32x4*)(vsq + (size_t)tok_ * 8); \
        const f32x4 a = p1[0], b = p1[1], c = p2[0], d = p2[1]; \
        const float mean = (((a[0] + a[1]) + (a[2] + a[3])) + ((b[0] + b[1]) + (b[2] + b[3]))) * (1.0f / DM), var = (((c[0] + c[1]) + (c[2] + c[3])) + ((d[0] + d[1]) + (d[2] + d[3]))) * (1.0f / DM) - mean * mean; \
        st[(buf_) * 256 + tid] = mean; st[(buf_) * 256 + 128 + tid] = __builtin_amdgcn_rsqf(fmaxf(var, 0.f) + LN_EPS); } } while (0)
#define SP_WTILE(g_) do { const float* wp = Ws + ((size_t)(g_) * 128 + r4) * 128 + sbase; \
        _Pragma("unroll") for (int c = 0; c < 4; ++c) { const f32x4 a = *(const GAS f32x4*)(wp + 8 * c), b = *(const GAS f32x4*)(wp + 8 * c + 4); const int s0 = sbase + 8 * c; float w[8] = {a[0], a[1], a[2], a[3], b[0], b[1], b[2], b[3]}; \
            _Pragma("unroll") for (int j = 0; j < 8; ++j) w[j] = (s0 + j <= r4) ? w[j] : 0.f; \
            u32x4 o; o.x = cvt_pk_bf16(w[0], w[1]); o.y = cvt_pk_bf16(w[2], w[3]); o.z = cvt_pk_bf16(w[4], w[5]); o.w = cvt_pk_bf16(w[6], w[7]); \
            const int chunk = (sbase >> 3) + c; *(LAS u32x4*)(Wl + r4 * 256 + ((chunk ^ (r4 & 15)) << 4)) = o; } } while (0)
#define SP_VLOAD(unit_, raw_) do { const bf16_t* vp = VT + (size_t)(((unit_) & 7) * 128 + r4) * ldt + ((unit_) >> 3) * 128 + sbase; \
        _Pragma("unroll") for (int c = 0; c < 4; ++c) raw_[c] = *(const GAS u32x4*)(vp + 8 * c); } while (0)
#define SP_VSTORE(unit_, buf_, raw_) do { const float gl = lng[((unit_) & 7) * 128 + r4]; const LAS float* mu = st + (buf_) * 256; \
        _Pragma("unroll") for (int c = 0; c < 4; ++c) { const u32x4 raw = raw_[c]; const int s0 = sbase + 8 * c; float v[8] = {bf_lo(raw.x), bf_hi(raw.x), bf_lo(raw.y), bf_hi(raw.y), bf_lo(raw.z), bf_hi(raw.z), bf_lo(raw.w), bf_hi(raw.w)}; \
            _Pragma("unroll") for (int j = 0; j < 8; ++j) v[j] = (v[j] - mu[s0 + j]) * mu[128 + s0 + j] * gl; \
            u32x4 o; o.x = cvt_pk_bf16(v[0], v[1]); o.y = cvt_pk_bf16(v[2], v[3]); o.z = cvt_pk_bf16(v[4], v[5]); o.w = cvt_pk_bf16(v[6], v[7]); \
            const int chunk = (sbase >> 3) + c; *(LAS u32x4*)(Vl + (buf_) * 32768 + r4 * 256 + ((chunk ^ vswz) << 4)) = o; } } while (0)
    if (c0 >= nunits) return;
    u32x4 vraw[4];
    SP_WTILE(c0 & 7); SP_STATS(c0, 0); SP_VLOAD(c0, vraw);
    __syncthreads();
    SP_VSTORE(c0, 0, vraw);
    if (c0 + G < nunits) SP_STATS(c0 + G, 1);
    __syncthreads();
    int it = 0;
    for (int unit = c0; unit < nunits; unit += G, ++it) {
        const int cur = it & 1, nxt = cur ^ 1, un = unit + G, un2 = unit + 2 * G;
        const int bc = unit >> 3, g = unit & 7, tok0 = bc * 128, ch0 = g * 128;
        if (un < nunits) SP_VLOAD(un, vraw);
        const LAS unsigned char* Vc = Vl + cur * 32768;
#pragma unroll
        for (int ti = 0; ti < 2; ++ti) {
            const int tt = 2 * tp + ti, brow = tt * 32 + q, bswz = brow & 15, nks = 2 * (tt + 1);
            const float bias = bs[g * 128 + tt * 32 + q];
            const size_t off = (size_t)(tok0 + tt * 32 + q) * DM + ch0 + ct * 32 + 16 * hh;
            const u32x4 ua = *(const GAS u32x4*)(U + off), ub = *(const GAS u32x4*)(U + off + 8);
            f32x16 C;
#pragma unroll
            for (int r = 0; r < 16; ++r) C[r] = 0.f;
            for (int ks = 0; ks < nks; ++ks) { const int chunk = 2 * ks + hh;
                const bf16x8 A = lds_frag(Vc + arow * 256 + ((chunk ^ aswz) << 4)), B = lds_frag(Wl + brow * 256 + ((chunk ^ bswz) << 4));
                C = __builtin_amdgcn_mfma_f32_32x32x16_bf16(A, B, C, 0, 0, 0); }
            u32x4 oa, ob;
            oa.x = cvt_pk_bf16(bf_lo(ua.x) * (C[0] + bias), bf_hi(ua.x) * (C[1] + bias)); oa.y = cvt_pk_bf16(bf_lo(ua.y) * (C[2] + bias), bf_hi(ua.y) * (C[3] + bias));
            oa.z = cvt_pk_bf16(bf_lo(ua.z) * (C[4] + bias), bf_hi(ua.z) * (C[5] + bias)); oa.w = cvt_pk_bf16(bf_lo(ua.w) * (C[6] + bias), bf_hi(ua.w) * (C[7] + bias));
            ob.x = cvt_pk_bf16(bf_lo(ub.x) * (C[8] + bias), bf_hi(ub.x) * (C[9] + bias)); ob.y = cvt_pk_bf16(bf_lo(ub.y) * (C[10] + bias), bf_hi(ub.y) * (C[11] + bias));
            ob.z = cvt_pk_bf16(bf_lo(ub.z) * (C[12] + bias), bf_hi(ub.z) * (C[13] + bias)); ob.w = cvt_pk_bf16(bf_lo(ub.w) * (C[14] + bias), bf_hi(ub.w) * (C[15] + bias));
            *(GAS u32x4*)(Y + off) = oa; *(GAS u32x4*)(Y + off + 8) = ob;
        }
        if (un < nunits) {
            if (!wfixed) { __syncthreads(); SP_WTILE(un & 7); }
            SP_VSTORE(un, nxt, vraw);
            if (un2 < nunits) SP_STATS(un2, cur);
        }
        __syncthreads();
    }
#undef SP_STATS
#undef SP_WTILE
#undef SP_VLOAD
#undef SP_VSTORE
}

__device__ __forceinline__ int swz64(int row) { return ((row >> 1) & 3) | (((row >> 4) & 1) << 2); }
__device__ __forceinline__ void attn_phase(LAS unsigned char* lds, const bf16_t* QK, const bf16_t* Vt, bf16_t* O, int c0, int G, int bhend, int ldt) {
    int tid_ = threadIdx.x; asm volatile("" : "+v"(tid_));
    const int tid = tid_, lane = tid & 63, wid = __builtin_amdgcn_readfirstlane(tid >> 6), q = lane & 31, hh = lane >> 5;
    const int srow = tid >> 3, sc16 = tid & 7, soff = srow * 128 + ((sc16 ^ swz64(srow)) << 4);
    const int arow = rowmap32(q), sw = swz64(arow);
    LAS unsigned* flags = (LAS unsigned*)(lds + 32768);
    for (int bh = c0; bh < bhend; bh += G) {
        const int b = bh >> 4, h = bh & 15; const size_t tokbase = (size_t)b * SEQ;
        const bf16_t* kg = QK + (tokbase + srow) * 2048 + 1024 + h * 64 + sc16 * 8;
        const bf16_t* vg = Vt + (size_t)(h * 64 + srow) * ldt + tokbase + sc16 * 8;
        for (int qb = 7; qb >= 0; --qb) {
            const int q0 = qb * 256 + 32 * wid, nt = 4 * (qb + 1);
            bf16x8 qf[4];
            { const bf16_t* qp = QK + (tokbase + q0 + q) * 2048 + h * 64 + 8 * hh;
#pragma unroll
              for (int ds = 0; ds < 4; ++ds) qf[ds] = *(const GAS bf16x8*)(qp + 16 * ds); }
            float carry = 1.f; f32x16 o0, o1; bool alive = true;
#pragma unroll
            for (int r = 0; r < 16; ++r) { o0[r] = 0.f; o1[r] = 0.f; }
            u32x4 kreg = *(const GAS u32x4*)(kg + (size_t)(64 * (nt - 1)) * 2048), vreg = *(const GAS u32x4*)(vg + 64 * (nt - 1));
            u32x4 kA = *(const GAS u32x4*)(kg + (size_t)(64 * (nt - 2)) * 2048), vA = *(const GAS u32x4*)(vg + 64 * (nt - 2));
            *(LAS u32x4*)(lds + soff) = kreg; *(LAS u32x4*)(lds + 8192 + soff) = vreg;
            __syncthreads();
            bool fin = false;
#define ATT_ITER(i, KL, VL, KW, VW) { \
                const int kt = nt - 1 - i; LAS unsigned char* cur = lds + (i & 1) * 16384; LAS unsigned char* nxt = lds + ((i & 1) ^ 1) * 16384; \
                if (i + 2 < nt) { KL = *(const GAS u32x4*)(kg + (size_t)(64 * (kt - 2)) * 2048); VL = *(const GAS u32x4*)(vg + 64 * (kt - 2)); } \
                if (alive && 64 * kt <= q0 + 30) { \
_Pragma("unroll") \
                    for (int sub = 1; sub >= 0; --sub) { \
                        const int ksub = 64 * kt + 32 * sub; \
                        if (ksub <= q0 + 30) { \
                            f32x16 S; \
_Pragma("unroll") \
                            for (int r = 0; r < 16; ++r) S[r] = 0.f; \
_Pragma("unroll") \
                            for (int ds = 0; ds < 4; ++ds) S = __builtin_amdgcn_mfma_f32_32x32x16_bf16(lds_frag(cur + (32 * sub + arow) * 128 + (((2 * ds + hh) ^ sw) << 4)), qf[ds], S, 0, 0, 0); \
                            float e[16]; \
                            if (ksub + 31 >= q0) { const int kq = (q0 + q) - (ksub + 16 * hh); \
_Pragma("unroll") \
                                for (int r = 0; r < 16; ++r) { const float x = __builtin_amdgcn_exp2f(__builtin_fminf(S[r], 15.0f)); e[r] = (r >= kq) ? 0.f : x; } \
                            } else { \
_Pragma("unroll") \
                                for (int r = 0; r < 16; ++r) e[r] = __builtin_amdgcn_exp2f(__builtin_fminf(S[r], 15.0f)); } \
                            float PL = 1.f, PH = 1.f, al[8], ah[8]; \
_Pragma("unroll") \
                            for (int r = 0; r < 8; ++r) { al[r] = e[r] * PL; PL = __builtin_fmaf(PL, e[r], PL); ah[r] = e[r + 8] * PH; PH = __builtin_fmaf(PH, e[r + 8], PH); } \
                            const float iL = __builtin_amdgcn_rcpf(PL), iH = __builtin_amdgcn_rcpf(PH), s = iL * iH; \
                            const float tp = __shfl_xor(s, 32); \
                            const float mult = hh ? carry : carry * tp; \
                            carry = carry * s * tp; \
                            const float cH = iH * mult, cL = iL * cH; \
                            u32x4 p0, p1; \
                            p0.x = cvt_pk_bf16(al[0] * cL, al[1] * cL); p0.y = cvt_pk_bf16(al[2] * cL, al[3] * cL); p0.z = cvt_pk_bf16(al[4] * cL, al[5] * cL); p0.w = cvt_pk_bf16(al[6] * cL, al[7] * cL); \
                            p1.x = cvt_pk_bf16(ah[0] * cH, ah[1] * cH); p1.y = cvt_pk_bf16(ah[2] * cH, ah[3] * cH); p1.z = cvt_pk_bf16(ah[4] * cH, ah[5] * cH); p1.w = cvt_pk_bf16(ah[6] * cH, ah[7] * cH); \
                            const bf16x8 pb0 = __builtin_bit_cast(bf16x8, p0), pb1 = __builtin_bit_cast(bf16x8, p1); \
                            const LAS unsigned char* vb = cur + 8192 + arow * 128; \
                            o0 = __builtin_amdgcn_mfma_f32_32x32x16_bf16(lds_frag(vb + (((4 * sub + 2 * hh) ^ sw) << 4)), pb0, o0, 0, 0, 0); \
                            o0 = __builtin_amdgcn_mfma_f32_32x32x16_bf16(lds_frag(vb + (((4 * sub + 2 * hh + 1) ^ sw) << 4)), pb1, o0, 0, 0, 0); \
                            o1 = __builtin_amdgcn_mfma_f32_32x32x16_bf16(lds_frag(vb + 4096 + (((4 * sub + 2 * hh) ^ sw) << 4)), pb0, o1, 0, 0, 0); \
                            o1 = __builtin_amdgcn_mfma_f32_32x32x16_bf16(lds_frag(vb + 4096 + (((4 * sub + 2 * hh + 1) ^ sw) << 4)), pb1, o1, 0, 0, 0); \
                        } \
                    } \
                } \
                alive = __builtin_amdgcn_ballot_w64(carry != 0.f) != 0ull; \
                if (lane == 0) flags[(i & 1) * 8 + wid] = alive ? 1u : 0u; \
                if (i + 1 < nt) { *(LAS u32x4*)(nxt + soff) = KW; *(LAS u32x4*)(nxt + 8192 + soff) = VW; } \
                __syncthreads(); \
                { const LAS u32x4* fp = (const LAS u32x4*)(flags + (i & 1) * 8); const u32x4 fa = fp[0], fb = fp[1]; \
                  if (((fa.x | fa.y) | (fa.z | fa.w) | (fb.x | fb.y) | (fb.z | fb.w)) == 0u) { fin = true; } } \
            }
            for (int i2 = 0; i2 < nt && !fin; i2 += 2) {
                ATT_ITER(i2, kreg, vreg, kA, vA)
                if (fin) break;
                ATT_ITER((i2 + 1), kA, vA, kreg, vreg)
            }
#undef ATT_ITER
            bf16_t* op = O + (tokbase + q0 + q) * DM + h * 64 + 16 * hh;
            u32x4 w;
            w.x = cvt_pk_bf16(o0[0], o0[1]); w.y = cvt_pk_bf16(o0[2], o0[3]); w.z = cvt_pk_bf16(o0[4], o0[5]); w.w = cvt_pk_bf16(o0[6], o0[7]); *(GAS u32x4*)(op) = w;
            w.x = cvt_pk_bf16(o0[8], o0[9]); w.y = cvt_pk_bf16(o0[10], o0[11]); w.z = cvt_pk_bf16(o0[12], o0[13]); w.w = cvt_pk_bf16(o0[14], o0[15]); *(GAS u32x4*)(op + 8) = w;
            w.x = cvt_pk_bf16(o1[0], o1[1]); w.y = cvt_pk_bf16(o1[2], o1[3]); w.z = cvt_pk_bf16(o1[4], o1[5]); w.w = cvt_pk_bf16(o1[6], o1[7]); *(GAS u32x4*)(op + 32) = w;
            w.x = cvt_pk_bf16(o1[8], o1[9]); w.y = cvt_pk_bf16(o1[10], o1[11]); w.z = cvt_pk_bf16(o1[12], o1[13]); w.w = cvt_pk_bf16(o1[14], o1[15]); *(GAS u32x4*)(op + 40) = w;
        }
    }
}

#define XB_TMO      128
#define XB_XCNT(j)  (256  + 64 * (j))
#define XB_XSUB(j)  (1280 + 64 * (j))
#define XB_XGEN(j)  (2304 + 64 * (j))
#define XB_TOP      3328
#define XB_TOPGEN   3392
#define XCD_BAR_WORDS 3456
#define XB_SPIN_CAP (1u << 18)

__device__ __forceinline__ unsigned xb_ld(unsigned* p)              { return __hip_atomic_load(p, __ATOMIC_RELAXED, __HIP_MEMORY_SCOPE_AGENT); }
__device__ __forceinline__ unsigned xb_add(unsigned* p, unsigned v) { return __hip_atomic_fetch_add(p, v, __ATOMIC_RELAXED, __HIP_MEMORY_SCOPE_AGENT); }
__device__ __forceinline__ unsigned xb_xcc_id() { return (unsigned)__builtin_amdgcn_s_getreg((3 << 11) | 20) & 0xFu; }
#define XB_SPIN(cond, bar) do { unsigned _sp = 0; while (cond) { __builtin_amdgcn_s_sleep(1); \
    if ((++_sp & 255u) == 0u) { if (xb_ld(&(bar)[XB_TMO])) break; if (_sp > XB_SPIN_CAP) { atomicAdd(&(bar)[XB_TMO], 1u); break; } } } } while (0)

struct XcdBarrier {
    unsigned* bar; unsigned x;
    volatile LAS unsigned* st;
};

__device__ __forceinline__ XcdBarrier xcd_barrier_post(unsigned* bar, volatile LAS unsigned* st) {
    XcdBarrier b; b.bar = bar; b.x = xb_xcc_id(); b.st = st;
    if (threadIdx.x == 0) (void)xb_add(&bar[XB_XCNT(b.x)], 1u);
    return b;
}
__device__ __forceinline__ void xcd_barrier_complete(unsigned* bar, unsigned x, unsigned& nloc, unsigned& nx) {
    const unsigned G = gridDim.x * gridDim.y * gridDim.z;
    unsigned sum, cnt, mine, sp = 0u;
    for (;;) {
        sum = 0u; cnt = 0u; mine = 0u;
#pragma unroll
        for (unsigned j = 0; j < 16; ++j) { const unsigned c = xb_ld(&bar[XB_XCNT(j)]); sum += c; cnt += (c > 0u) ? 1u : 0u; mine = (j == x) ? c : mine; }
        if (sum == G) break;
        __builtin_amdgcn_s_sleep(1);
        if ((++sp & 255u) == 0u) { if (xb_ld(&bar[XB_TMO])) break; if (sp > XB_SPIN_CAP) { atomicAdd(&bar[XB_TMO], 1u); break; } }
    }
    nloc = mine > 0u ? mine : 1u; nx = cnt > 0u ? cnt : 1u;
}

__device__ __forceinline__ void xcd_barrier(const XcdBarrier& b) {
    asm volatile("s_waitcnt vmcnt(0)" ::: "memory");
    __syncthreads();
    if (threadIdx.x == 0) {
        unsigned* bar = b.bar;
        __builtin_amdgcn_s_waitcnt(0);
        unsigned nloc = b.st[0], nx = b.st[1];
        if (nloc == 0u) { xcd_barrier_complete(bar, b.x, nloc, nx); b.st[0] = nloc; b.st[1] = nx; }
        const unsigned old = xb_add(&bar[XB_XSUB(b.x)], 1u);
        const unsigned gen = old / nloc;
        if (old + 1u == (gen + 1u) * nloc) {
            __builtin_amdgcn_fence(__ATOMIC_RELEASE, "agent");
            asm volatile("s_waitcnt vmcnt(0)" ::: "memory");
            const unsigned og = xb_add(&bar[XB_TOP], 1u);
            const unsigned tg = og / nx;
            if (og + 1u == (tg + 1u) * nx) xb_add(&bar[XB_TOPGEN], 1u);
            else XB_SPIN(xb_ld(&bar[XB_TOPGEN]) == tg, bar);
            __builtin_amdgcn_fence(__ATOMIC_ACQUIRE, "agent");
            xb_add(&bar[XB_XGEN(b.x)], 1u);
            asm volatile("s_waitcnt vmcnt(0)" ::: "memory");
        } else {
            XB_SPIN(xb_ld(&bar[XB_XGEN(b.x)]) == gen, bar);
            __builtin_amdgcn_fence(__ATOMIC_ACQUIRE, "agent");
            asm volatile("s_waitcnt vmcnt(0)" ::: "memory");
        }
    }
    __syncthreads();
}


__device__ __forceinline__ void xcc_barrier(unsigned* bar, unsigned x, unsigned nloc) {
    asm volatile("s_waitcnt vmcnt(0)" ::: "memory");
    __syncthreads();
    if (threadIdx.x == 0) {
        const unsigned old = xb_add(&bar[4096 + 64 * x], 1u), gen = old / nloc;
        const bool last = (old + 1u == (gen + 1u) * nloc);
        if (last) xb_add(&bar[4608 + 64 * x], 1u);
        __builtin_amdgcn_fence(__ATOMIC_ACQUIRE, "agent");
        if (!last) XB_SPIN(xb_ld(&bar[4608 + 64 * x]) == gen, bar);
        asm volatile("s_waitcnt vmcnt(0)" ::: "memory");
    }
    __syncthreads();
}

#ifndef MK_MULTI
#define MK_MULTI 0
#endif
constexpr int N_PHASES = 1 + DEPTH * 10;
#ifndef PMASK
#define PMASK 0x1ff
#endif
struct Args { Ptrs p; int ph_lo, ph_hi; };
static_assert(sizeof(Args) == 15 * 8 + 8, "Args has no padding");

template <class Epi> __device__ __forceinline__ void run_gemm(LAS unsigned char* lds, const bf16_t* A, const bf16_t* Bt, int M, int N, int K, const Epi& E, int c, int i0 = 0, int ni = 1 << 30) {
    pg8::Gemm g{A, Bt, M, N, K}; pg8::StaticOrder S; S.init(M, N, (int)gridDim.x, c); S.i0 = i0; S.ni = ni;
    pg8::gemm_phase<Epi, pg8::StaticOrder, true, true>(lds, g, S, E);
}

__global__ void __launch_bounds__(NTHREADS, 2) fwd_kernel(Args a) {
    extern __shared__ __attribute__((aligned(16))) unsigned char lds_raw[];
    LAS unsigned char* lds = (LAS unsigned char*)lds_raw;
    cg::grid_group grid = cg::this_grid();
    volatile LAS unsigned* bst = (volatile LAS unsigned*)(lds + 131072 + 64);
    if (threadIdx.x < 2) bst[threadIdx.x] = 0u;
    __syncthreads();
    XcdBarrier xbar = xcd_barrier_post((unsigned*)(a.p.ws + WS_BAR), bst);
    unsigned* barw = (unsigned*)(a.p.ws + WS_BAR);
    unsigned* tick = barw + 3520;
    if (threadIdx.x == 0) { const unsigned x = xbar.x; bst[2] = (x < 8u) ? __hip_atomic_fetch_add(tick + 64 * x, 1u, __ATOMIC_RELAXED, __HIP_MEMORY_SCOPE_AGENT) : 0u; }
    __syncthreads();
    const int my_ticket = (int)bst[2];
    int vc = (int)blockIdx.x; bool local_ok = false;
    const bool xl = (gridDim.x == 256);
#define AS_GLOBAL(T, p) ((T*)(__attribute__((address_space(1))) T*)(p))
    const Ptrs& P = a.p;
    for (int ph = a.ph_lo; ph < a.ph_hi; ++ph) {
        int tid_ = threadIdx.x; asm volatile("" : "+v"(tid_));
        const int tid = tid_, lane = tid & 63, wave = __builtin_amdgcn_readfirstlane(tid >> 6), G = gridDim.x;
        const int gw = blockIdx.x * NWAVES + wave, NGW = G * NWAVES;
        const int xx = vc & 7, jj = vc >> 3;
        unsigned char* ws_ = P.ws; asm volatile("" : "+s"(ws_)); unsigned char* ws = AS_GLOBAL(unsigned char, ws_);
        bf16_t* WB = (bf16_t*)(ws + WS_W); bf16_t* HN = (bf16_t*)(ws + WS_HN); bf16_t* FB = (bf16_t*)(ws + WS_F); bf16_t* BIG = (bf16_t*)(ws + WS_BIG);
        const size_t xtok = xl ? (size_t)8192 * xx : 0; const int ldt = xl ? 8192 : TOK;
        bf16_t* RB = xl ? BIG + (size_t)xx * (24 * MiB) : BIG;
        bf16_t* ACT = RB - xtok * DFF; bf16_t* UB = RB - xtok * DM; bf16_t* VTB = RB + (xl ? (size_t)8192 * DM : (size_t)TOK * DM) - xtok;
        bf16_t* QKB = RB - xtok * 2 * DM; bf16_t* VtB = RB + (xl ? (size_t)8192 * 2 * DM : (size_t)TOK * 2 * DM) - xtok;
        float* ss = (float*)(ws + WS_SS); float* vsum = (float*)(ws + WS_VSUM); float* vsq = (float*)(ws + WS_VSQ); float* rs = (float*)(ws + WS_RS); unsigned char* LO = ws + WS_LO;
        bf16_t* YB = (bf16_t*)P.out;
        if (ph == 0) { if constexpr (PMASK & 1) prologue_phase(P, lds, gw, NGW, wave, lane); }
        else {
            const int L = (ph - 1) / 10, k = (ph - 1) % 10, mix = L & 1, lm = L >> 1;
            if (k == 0 || k == 7) {
                const int li = 2 * L + (k == 7);
                EpiSwiGLU E{ACT, rs};
                if constexpr (PMASK & 2) run_gemm(lds, HN, WB + (size_t)li * W_FFN_STRIDE + W_GU, TOK, 2 * DFF, DM, E, vc, 0, xl ? 11 : (1 << 30));
            } else if (k == 1 || k == 8 || k == 5) {
                const bf16_t* A; const bf16_t* Bt; int K;
                if (k == 5) { A = YB; K = DM; Bt = mix ? WB + W_B0 + (size_t)lm * W_B_STRIDE + W_BO : WB + W_A0 + (size_t)lm * W_A_STRIDE + W_AOUT; }
                else { const int li = 2 * L + (k == 8); A = ACT; K = DFF; Bt = WB + (size_t)li * W_FFN_STRIDE + W_DN; }
                EpiStore<0, 1, 0> E{FB, DM, 0, 1.f, ss, nullptr, nullptr};
                const int useF = L * 3 + ((k == 1) ? 0 : 2);
                const bool halfFin = xl && k != 5 && useF != 0 && useF != DEPTH * 3 - 1;
                if (xl && k != 5) {
                    const int li = 2 * L + (k == 8), pi = (k == 1) ? 0 : 2;
                    const float* gpost = P.norm_post + (size_t)(L * 3 + pi) * DM;
#pragma unroll 1
                    for (int st_ = 0; st_ < 4; ++st_) { int st = st_; asm volatile("" : "+s"(st));
                        if ((st & 1) && !halfFin) continue;
                        if (!(st & 1)) { if constexpr (PMASK & 4) run_gemm(lds, A, Bt, TOK, DM, K, E, vc, st, 2); }
                        else { if constexpr (PMASK & 8) {
                                const int f0 = (32 * xx + 16 * (st >> 1)) * 256 + jj * 128 + wave, fe = (32 * xx + 16 * (st >> 1)) * 256 + jj * 128 + 128;
                                int lane2 = lane; asm volatile("" : "+v"(lane2));
                                fin_phase<false, false>(P.x, P.out, HN, LO, rs, FB, ss, gpost, 0.5f, f0, NWAVES, fe, lane2); } }
                        if ((st == 0 && !halfFin) || (st == 1 && halfFin)) { EpiSwiGLU E2{ACT, rs};
                            if constexpr (PMASK & 2) run_gemm(lds, HN, WB + (size_t)li * W_FFN_STRIDE + W_GU, TOK, 2 * DFF, DM, E2, vc, 11, 11); }
                        if (st_ < (halfFin ? 3 : 2)) { if (local_ok) xcc_barrier(barw, xbar.x, (unsigned)(G / 8)); else xcd_barrier(xbar); }
                    }
                } else {
                    if constexpr (PMASK & 4) run_gemm(lds, A, Bt, TOK, DM, K, E, vc);
                }
            } else if (k == 2 || k == 6 || k == 9) {
                if (xl && k != 6 && !(L == 0 && k == 2) && !(L == DEPTH - 1 && k == 9)) continue;
                const int pi = (k == 2) ? 0 : (k == 6) ? 1 : 2;
                const float* gpost = P.norm_post + (size_t)(L * 3 + pi) * DM;
                const float coef = (k == 6) ? 1.0f : 0.5f;
                if constexpr (PMASK & 8) {
                    const int f0 = xl ? (32 * xx + jj) * 256 + wave : gw, fs = xl ? NWAVES : NGW, fe = xl ? (32 * xx + jj) * 256 + 256 : TOK;
                    if (L == 0 && k == 2) fin_phase<true, false>(P.x, P.out, HN, LO, rs, FB, ss, gpost, coef, f0, fs, fe, lane);
                    else if (L == DEPTH - 1 && k == 9) fin_phase<false, true>(P.x, P.out, HN, LO, rs, FB, ss, gpost, coef, f0, fs, fe, lane);
                    else fin_phase<false, false>(P.x, P.out, HN, LO, rs, FB, ss, gpost, coef, f0, fs, fe, lane);
                }
            } else if (k == 3) {
                if (!mix) {
                    const bf16_t* Wi = WB + W_A0 + (size_t)lm * W_A_STRIDE + W_AIN;
                    EpiStore<1, 0, 1> E1{UB, DM, 0, 1.f, nullptr, nullptr, rs};
                    if constexpr (PMASK & 16) run_gemm(lds, HN, Wi, TOK, DM, DM, E1, vc);
                    EpiStore<1, 2, 2> E2{VTB, ldt, 0, 1.f, vsum, vsq, rs};
                    if constexpr (PMASK & 256) run_gemm(lds, Wi + (size_t)DM * DM, HN, DM, TOK, DM, E2, vc);
                } else {
                    const bf16_t* Wq = WB + W_B0 + (size_t)lm * W_B_STRIDE + W_BQKV;
                    EpiStore<0, 0, 1> E1{QKB, 2 * DM, 4, QSCALE, nullptr, nullptr, rs};
                    if constexpr (PMASK & 32) run_gemm(lds, HN, Wq, TOK, 2 * DM, DM, E1, vc);
                    EpiStore<0, 0, 2> E2{VtB, ldt, 0, 1.f, nullptr, nullptr, rs};
                    if constexpr (PMASK & 32) run_gemm(lds, Wq + (size_t)2 * DM * DM, HN, DM, TOK, DM, E2, vc);
                }
            } else {
                if (!mix) { if constexpr (PMASK & 64) spatial_phase(lds, UB, VTB, vsum, vsq, P.a_lng + (size_t)lm * DM, P.a_ws + (size_t)lm * 8 * 128 * 128, P.a_bs + (size_t)lm * 8 * 128, YB, xl ? 512 * xx + jj : (int)blockIdx.x, xl ? 32 : G, xl ? 512 * (xx + 1) : (TOK / 128) * 8, ldt); }
                else { if constexpr (PMASK & 128) attn_phase(lds, QKB, VtB, YB, xl ? 64 * xx + jj : (int)blockIdx.x, xl ? 32 : G, xl ? 64 * (xx + 1) : NB * NH, ldt); }
            }
        }
        if (ph + 1 < a.ph_hi) {
            if (a.ph_hi > 4096) grid.sync();
            else if (ph == 0 || !local_ok) xcd_barrier(xbar);
            else xcc_barrier(barw, xbar.x, (unsigned)(G / 8));
            if (ph == 0 && xl && xbar.x < 8u) {
                bool even = true;
                for (int j = 0; j < 8; ++j) even = even && (__hip_atomic_load(tick + 64 * j, __ATOMIC_RELAXED, __HIP_MEMORY_SCOPE_AGENT) == (unsigned)(G / 8));
                if (even) { vc = my_ticket * 8 + (int)xbar.x; local_ok = true; } }
        }
    }
}

extern "C" void kernel_launch(void* const* d_in, const int* in_sizes, int n_in, void* d_out, int out_size, void* d_ws, size_t ws_size, hipStream_t stream) {
    static int grid = 0;
    if (grid == 0) {
        if (n_in != 13 || in_sizes[0] != TOK * DM || out_size != TOK * DM || ws_size < WS_END) {
            fprintf(stderr, "kernel_launch: unexpected shapes (n_in %d, in0 %d, out %d, ws %zu need %zu); nothing launched\n", n_in, n_in > 0 ? in_sizes[0] : -1, out_size, ws_size, (size_t)WS_END); grid = -1; return; }
        int dev = 0, cus = 0, per_cu = 0;
        if (hipGetDevice(&dev) != hipSuccess || hipDeviceGetAttribute(&cus, hipDeviceAttributeMultiprocessorCount, dev) != hipSuccess) { fprintf(stderr, "kernel_launch: device query failed\n"); grid = -1; return; }
        if (hipFuncSetAttribute((const void*)fwd_kernel, hipFuncAttributeMaxDynamicSharedMemorySize, LDS_BYTES) != hipSuccess) { fprintf(stderr, "kernel_launch: hipFuncSetAttribute failed\n"); grid = -1; return; }
        if (hipOccupancyMaxActiveBlocksPerMultiprocessor(&per_cu, (const void*)fwd_kernel, NTHREADS, LDS_BYTES) != hipSuccess || per_cu < 1) { fprintf(stderr, "kernel_launch: occupancy query says %d blocks per CU\n", per_cu); per_cu = 1; }
        (void)hipGetLastError();
        grid = cus;
        fprintf(stderr, "kernel_launch: grid %d (cus %d, per_cu %d)\n", grid, cus, per_cu);
    }
    if (grid < 0) return;
    if (hipMemsetAsync((char*)d_ws + WS_BAR, 0, BAR_BYTES, stream) != hipSuccess) { fprintf(stderr, "kernel_launch: hipMemsetAsync failed\n"); return; }
    Args a{};
    const float** pp = (const float**)&a.p;
    for (int i = 0; i < 13; ++i) pp[i] = (const float*)d_in[i];
    a.p.out = (float*)d_out; a.p.ws = (unsigned char*)d_ws;
#if MK_MULTI
    for (int ph = 0; ph < N_PHASES; ++ph) { a.ph_lo = ph; a.ph_hi = ph + 1; hipLaunchKernelGGL(fwd_kernel, dim3(grid), dim3(NTHREADS), LDS_BYTES, stream, a); }
#else
    a.ph_lo = 0; a.ph_hi = N_PHASES;
    void* args[] = {&a};
    const hipError_t e = hipLaunchCooperativeKernel((const void*)fwd_kernel, dim3(grid), dim3(NTHREADS), args, LDS_BYTES, stream);
    if (e != hipSuccess) fprintf(stderr, "kernel_launch: cooperative launch failed: %s (grid %d)\n", hipGetErrorString(e), grid);
#endif
}
```

```cpp
#include <hip/hip_runtime.h>
#include <hip/hip_cooperative_groups.h>
#include <cstdio>
#include <cstdint>
namespace cg = cooperative_groups;
namespace pg8 {
#define PG8_LAS __attribute__((address_space(3)))
typedef unsigned short bf16_t;
typedef short bf16x8 __attribute__((ext_vector_type(8)));
typedef float f32x4 __attribute__((ext_vector_type(4)));
typedef unsigned u32x4 __attribute__((ext_vector_type(4)));
constexpr int BM = 256, BK = 64, HALF = 128, HTB = HALF * BK * 2  , STAGE_BYTES = 8 * HTB, NXCD = 8, WGM = 8;

__host__ __device__ __forceinline__ int lds_byte(int r, int c) { const int st = (r >> 4) * 2 + (c >> 5), rr = r & 15, cc = c & 31, ob = rr * 64 + cc * 2; return st * 1024 + (ob ^ (((ob >> 9) & 1) << 5)); }
__host__ __device__ __forceinline__ void stage_rc(int b, int& R, int& C) { const int st = b / 1024, sb = b % 1024, swz = sb ^ (((sb >> 9) & 1) << 5); R = (st >> 1) * 16 + swz / 64; C = (st & 1) * 32 + (swz % 64) / 2; }
__host__ __device__ __forceinline__ int perm32(int rho) { const int n = rho >> 4, i = rho & 15; return 8 * (i >> 2) + 4 * n + (i & 3); }

struct Unit { int pm, pn; };
struct Gemm { const bf16_t* A; const bf16_t* Bt; int M, N, K; };

struct StaticOrder {
    int nM, nN, nwg, G, c, i0 = 0, ni = 1 << 30;
    __host__ __device__ void init(int M, int N, int G_, int c_) { nM = M / BM; nN = N / BM; nwg = nM * nN; G = G_; c = c_; }
    __host__ __device__ bool next(int i, Unit& u) const {
        if (i >= ni) return false;
        const long L = (long)(i + i0) * G + c; if (L >= nwg) return false;
        int wgid = (int)L; { const int q = nwg / NXCD, r = nwg % NXCD, xcd = wgid % NXCD, off = wgid / NXCD; wgid = (xcd < r ? xcd * (q + 1) : r * (q + 1) + (xcd - r) * q) + off; }
        const int nig = WGM * nN, gid = wgid / nig, fm = gid * WGM, gsz = (nM - fm) < WGM ? (nM - fm) : WGM;
        u.pm = fm + ((wgid % nig) % gsz); u.pn = (wgid % nig) / gsz; return true;
    }
    __device__ __forceinline__ void a_ready(const Unit&) const {}
    __device__ __forceinline__ void done(const Unit&) const {}
};
__device__ __forceinline__ unsigned cvt_pk_bf16(float lo, float hi) { unsigned r; asm volatile("v_cvt_pk_bf16_f32 %0, %1, %2" : "=v"(r) : "v"(lo), "v"(hi)); return r; }
typedef float f32x2 __attribute__((ext_vector_type(2)));
__device__ __forceinline__ f32x2 gelu_pk(f32x2 v) {
    const f32x2 av = __builtin_elementwise_abs(v), d = av * 0.2316418882f + 1.0f;
    f32x2 t; t.x = __builtin_amdgcn_rcpf(d.x); t.y = __builtin_amdgcn_rcpf(d.y);
    f32x2 q = t * 0.5307027145f + (-0.7265760135f); q = q * t + 0.7107068705f; q = q * t + (-0.142248368f); q = q * t + 0.127414796f; q = q * t;
    const f32x2 s = (v * v) * (-0.72134752044f);
    f32x2 e; e.x = __builtin_amdgcn_exp2f(s.x); e.y = __builtin_amdgcn_exp2f(s.y);
    const f32x2 m = v * (q * e), r = v - m;
    f32x2 o; o.x = v.x < 0.f ? m.x : r.x; o.y = v.y < 0.f ? m.y : r.y; return o;
}
template <class Epi, class Sched, bool ALIGN_EPI = false, bool SP2 = false>
__device__ __forceinline__ void gemm_phase(PG8_LAS unsigned char* lds, const Gemm g, const Sched& S, const Epi& E) {
    int tid_ = threadIdx.x; asm volatile("" : "+v"(tid_));
    const int tid = tid_, wid = __builtin_amdgcn_readfirstlane(tid >> 6), lane = tid & 63, wr = wid >> 2, wc = wid & 3, fr = lane & 15, fq = lane >> 4;
    const int K = g.K, nt = K / BK;
    unsigned voffA[2], voffB[2];
#pragma unroll
    for (int i = 0; i < 2; ++i) { int R, C; stage_rc(tid * 16 + i * 8192, R, C); const int Rb = Epi::PERM ? ((R & ~31) + perm32(R & 31)) : R;
        voffA[i] = (unsigned)(R * K + C) * 2u; voffB[i] = (unsigned)(Rb * K + C) * 2u; }
    const size_t kstep = (size_t)(BK * 2);
    const size_t hstep = (size_t)HALF * K * 2;
    const size_t tstep = 2 * hstep;
    const unsigned ldsw = (unsigned)wid * 1024u;
    const int aoff = lds_byte(wr * 64 + fr, fq * 8), boff = lds_byte(wc * 32 + fr, fq * 8);
#define PG8_SA(b, h) (((b) * 2 + (h)) * HTB)
#define PG8_SB(b, h) ((4 + (b) * 2 + (h)) * HTB)
#define PG8_STAGE(bufoff, gbase, voff) do { _Pragma("unroll") for (int _i = 0; _i < 2; ++_i) \
        __builtin_amdgcn_global_load_lds((const unsigned*)((const char*)(gbase) + (voff)[_i]), (PG8_LAS unsigned*)(lds + (bufoff) + ldsw + _i * 8192), 16, 0, 0); } while (0)
#define PG8_LDA(dst, b, h) do { _Pragma("unroll") for (int m = 0; m < 4; ++m) _Pragma("unroll") for (int k = 0; k < 2; ++k) dst[m][k] = *(const PG8_LAS bf16x8*)(lds + PG8_SA(b, h) + aoff + m * 2048 + k * 1024); } while (0)
#define PG8_LDB(dst, b, h) do { _Pragma("unroll") for (int n = 0; n < 2; ++n) _Pragma("unroll") for (int k = 0; k < 2; ++k) dst[n][k] = *(const PG8_LAS bf16x8*)(lds + PG8_SB(b, h) + boff + n * 2048 + k * 1024); } while (0)
#define PG8_MMA(ai, bj, At, Bt) do { __builtin_amdgcn_s_setprio(1); _Pragma("unroll") for (int m = 0; m < 4; ++m) _Pragma("unroll") for (int n = 0; n < 2; ++n) _Pragma("unroll") for (int k = 0; k < 2; ++k) \
        acc[ai][bj][m][n] = __builtin_amdgcn_mfma_f32_16x16x32_bf16(Bt[n][k], At[m][k], acc[ai][bj][m][n], 0, 0, 0); __builtin_amdgcn_s_setprio(0); } while (0)
#define PG8_WAIT_V(n) asm volatile("s_waitcnt vmcnt(" #n ")" ::: "memory")
#define PG8_WAIT_L(n) asm volatile("s_waitcnt lgkmcnt(" #n ")" ::: "memory")
#define PG8_BAR __builtin_amdgcn_s_barrier()
#define PG8_SCHED __builtin_amdgcn_sched_barrier(0)
    Unit cur, nxt; int ui = 0;
    if (!S.next(0, cur)) return;
    f32x4 acc[2][2][4][2];
#pragma unroll
    for (int a = 0; a < 2; ++a)
#pragma unroll
        for (int b = 0; b < 2; ++b)
#pragma unroll
            for (int m = 0; m < 4; ++m)
#pragma unroll
                for (int n = 0; n < 2; ++n) acc[a][b][m][n] = (f32x4){0.f, 0.f, 0.f, 0.f};
    bf16x8 At[4][2], B0[2][2], B1[2][2];
    const char* cA = (const char*)g.A + (size_t)cur.pm * tstep; const char* cB = (const char*)g.Bt + (size_t)cur.pn * tstep;
    S.a_ready(cur);
    float epre[8];
    if constexpr (Epi::PREFETCH) E.prefetch(cur, wr, fr, epre);
    if constexpr (SP2) {
        PG8_STAGE(PG8_SB(0, 0), cB, voffB); PG8_STAGE(PG8_SB(0, 1), cB + hstep, voffB); PG8_STAGE(PG8_SA(0, 0), cA, voffA); PG8_STAGE(PG8_SA(0, 1), cA + hstep, voffA);
        if (wr == 1) PG8_BAR;
        PG8_WAIT_V(2); PG8_BAR;
        PG8_STAGE(PG8_SB(1, 0), cB + kstep, voffB); PG8_STAGE(PG8_SA(1, 0), cA + kstep, voffA); PG8_STAGE(PG8_SB(1, 1), cB + hstep + kstep, voffB);
        PG8_WAIT_V(6); PG8_BAR;
    } else {
        PG8_STAGE(PG8_SB(0, 0), cB, voffB); PG8_STAGE(PG8_SA(0, 0), cA, voffA); PG8_STAGE(PG8_SB(0, 1), cB + hstep, voffB); PG8_STAGE(PG8_SA(0, 1), cA + hstep, voffA);
        if (wr == 1) PG8_BAR;
        PG8_WAIT_V(4); PG8_BAR;
        PG8_STAGE(PG8_SB(1, 0), cB + kstep, voffB); PG8_STAGE(PG8_SA(1, 0), cA + kstep, voffA); PG8_STAGE(PG8_SB(1, 1), cB + hstep + kstep, voffB);
        PG8_WAIT_V(6); PG8_BAR;
    }
    for (;;) {
        const bool has_next = S.next(ui + 1, nxt);
        const char* nA = has_next ? (const char*)g.A + (size_t)nxt.pm * tstep : cA; const char* nB = has_next ? (const char*)g.Bt + (size_t)nxt.pn * tstep : cB;
        for (int t = 0; t < nt; t += 2) {
            const bool last = (t == nt - 2);
            const char* a1 = cA + (size_t)(t + 1) * kstep;
            const char* a2 = last ? nA : cA + (size_t)(t + 2) * kstep; const char* b2 = last ? nB : cB + (size_t)(t + 2) * kstep;
            const char* a3 = a2 + kstep; const char* b3 = b2 + kstep;
            if (last && has_next) S.a_ready(nxt);
            if constexpr (SP2) {
            PG8_LDB(B0, 0, 0); PG8_LDB(B1, 0, 1); PG8_SCHED; PG8_LDA(At, 0, 0); PG8_STAGE(PG8_SA(1, 1), a1 + hstep, voffA);
            PG8_WAIT_V(8); PG8_WAIT_L(0); PG8_BAR; PG8_MMA(0, 0, At, B0); PG8_MMA(0, 1, At, B1); PG8_BAR; PG8_SCHED;
            PG8_LDA(At, 0, 1); PG8_STAGE(PG8_SB(0, 0), b2, voffB); PG8_STAGE(PG8_SB(0, 1), b2 + hstep, voffB); PG8_STAGE(PG8_SA(0, 0), a2, voffA);
            PG8_WAIT_V(8); PG8_WAIT_L(0); PG8_BAR; PG8_MMA(1, 0, At, B0); PG8_MMA(1, 1, At, B1); PG8_BAR; PG8_SCHED;
            PG8_LDB(B0, 1, 0); PG8_LDB(B1, 1, 1); PG8_SCHED; PG8_LDA(At, 1, 0); PG8_STAGE(PG8_SA(0, 1), a2 + hstep, voffA);
            PG8_WAIT_V(8); PG8_WAIT_L(0); PG8_BAR; PG8_MMA(0, 0, At, B0); PG8_MMA(0, 1, At, B1); PG8_BAR; PG8_SCHED;
            PG8_LDA(At, 1, 1); PG8_STAGE(PG8_SB(1, 0), b3, voffB); PG8_STAGE(PG8_SB(1, 1), b3 + hstep, voffB); PG8_STAGE(PG8_SA(1, 0), a3, voffA);
            PG8_WAIT_V(8); PG8_WAIT_L(0); PG8_BAR; PG8_MMA(1, 0, At, B0); PG8_MMA(1, 1, At, B1); PG8_BAR; PG8_SCHED;
            } else {
            PG8_LDB(B0, 0, 0); PG8_SCHED; PG8_LDA(At, 0, 0); PG8_STAGE(PG8_SA(1, 1), a1 + hstep, voffA);
            PG8_WAIT_L(8); PG8_BAR; PG8_WAIT_L(0); PG8_MMA(0, 0, At, B0); PG8_BAR; PG8_SCHED;
            PG8_LDB(B1, 0, 1); PG8_STAGE(PG8_SB(0, 0), b2, voffB);
            PG8_BAR; PG8_WAIT_L(0); PG8_MMA(0, 1, At, B1); PG8_BAR;
            PG8_LDA(At, 0, 1); PG8_STAGE(PG8_SA(0, 0), a2, voffA);
            PG8_BAR; PG8_WAIT_L(0); PG8_MMA(1, 0, At, B0); PG8_BAR; PG8_SCHED;
            PG8_STAGE(PG8_SB(0, 1), b2 + hstep, voffB);
            PG8_WAIT_V(6); PG8_BAR; PG8_MMA(1, 1, At, B1); PG8_BAR;
            PG8_LDB(B0, 1, 0); PG8_SCHED; PG8_LDA(At, 1, 0); PG8_STAGE(PG8_SA(0, 1), a2 + hstep, voffA);
            PG8_WAIT_L(8); PG8_BAR; PG8_WAIT_L(0); PG8_MMA(0, 0, At, B0); PG8_BAR; PG8_SCHED;
            PG8_LDB(B1, 1, 1); PG8_STAGE(PG8_SB(1, 0), b3, voffB);
            PG8_BAR; PG8_WAIT_L(0); PG8_MMA(0, 1, At, B1); PG8_BAR;
            PG8_LDA(At, 1, 1); PG8_STAGE(PG8_SA(1, 0), a3, voffA);
            PG8_BAR; PG8_WAIT_L(0); PG8_MMA(1, 0, At, B0); PG8_BAR; PG8_SCHED;
            PG8_STAGE(PG8_SB(1, 1), b3 + hstep, voffB);
            PG8_WAIT_V(6); PG8_BAR; PG8_MMA(1, 1, At, B1); PG8_BAR;
            }
        }
        if constexpr (ALIGN_EPI) { if (wr == 0) PG8_BAR; }
        if constexpr (!Epi::AFTER_DRAIN) { if constexpr (Epi::PREFETCH) E(acc, cur, wr, wc, fr, fq, epre); else E(acc, cur, wr, wc, fr, fq); S.done(cur); }
        if (!has_next) break;
#pragma unroll
        for (int a = 0; a < 2; ++a)
#pragma unroll
            for (int b = 0; b < 2; ++b)
#pragma unroll
                for (int m = 0; m < 4; ++m)
#pragma unroll
                    for (int n = 0; n < 2; ++n) acc[a][b][m][n] = (f32x4){0.f, 0.f, 0.f, 0.f};
        cur = nxt; cA = nA; cB = nB; ++ui;
        if constexpr (Epi::PREFETCH) E.prefetch(cur, wr, fr, epre);
        if constexpr (ALIGN_EPI) { if (wr == 1) PG8_BAR; }
    }
    PG8_WAIT_V(0);
    if constexpr (!ALIGN_EPI) { if (wr == 0) PG8_BAR; }
    PG8_BAR;
    if constexpr (Epi::AFTER_DRAIN) { E.fused(acc, cur, wr, wc, fr, fq, lds, wid, lane); S.done(cur); }
#undef PG8_SA
#undef PG8_SB
#undef PG8_STAGE
#undef PG8_LDA
#undef PG8_LDB
#undef PG8_MMA
#undef PG8_WAIT_V
#undef PG8_WAIT_L
#undef PG8_BAR
#undef PG8_SCHED
}
}
#define LAS __attribute__((address_space(3)))
#define GAS __attribute__((address_space(1)))
using pg8::bf16_t; using pg8::f32x4; using pg8::u32x4; using pg8::bf16x8; using pg8::Unit; using pg8::cvt_pk_bf16; using pg8::f32x2; using pg8::gelu_pk;
typedef float f32x16 __attribute__((ext_vector_type(16)));
typedef unsigned u32x2 __attribute__((ext_vector_type(2)));

constexpr int TOK = 65536, DM = 1024, DFF = 2816, SEQ = 2048, NB = 32, NH = 16, DEPTH = 4;
constexpr float RMS_EPS = 1e-6f, LN_EPS = 1e-5f;
constexpr float QSCALE = 0.125f * 1.4426950408889634f;
constexpr int NTHREADS = 512, NWAVES = 8;
constexpr int LDS_BYTES = 132096;

constexpr size_t MiB = 1u << 20;
constexpr size_t WS_BAR = 0, BAR_BYTES = 32768;
constexpr size_t WS_SS = 1 * MiB, WS_VSUM = 5 * MiB, WS_VSQ = 7 * MiB;
constexpr size_t WS_W = 10 * MiB;
constexpr size_t WS_RS = 9 * MiB;
constexpr size_t WS_HN = 170 * MiB, WS_F = 298 * MiB, WS_BIG = 426 * MiB, WS_LO = 810 * MiB, WS_END = 874 * MiB;
static_assert(WS_W + 160 * MiB <= WS_HN, "ws map");
constexpr size_t W_FFN_STRIDE = (size_t)3 * DM * DFF, W_GU = 0, W_DN = (size_t)2 * DM * DFF;
constexpr size_t W_A0 = 8 * W_FFN_STRIDE, W_A_STRIDE = (size_t)3 * DM * DM, W_AIN = 0, W_AOUT = (size_t)2 * DM * DM;
constexpr size_t W_B0 = W_A0 + 2 * W_A_STRIDE, W_B_STRIDE = (size_t)4 * DM * DM, W_BQKV = 0, W_BO = (size_t)3 * DM * DM;
static_assert((W_B0 + 2 * W_B_STRIDE) * 2 == 160 * MiB, "weight map");

__device__ __forceinline__ float silu_mul(float g, float u) { const float e = __builtin_amdgcn_exp2f(-1.4426950408889634f * g); return g * __builtin_amdgcn_rcpf(1.0f + e) * u; }
struct EpiSwiGLU {
    static constexpr bool PERM = true, AFTER_DRAIN = false, PREFETCH = true; bf16_t* O; const float* rs;
    __device__ __forceinline__ void prefetch(const Unit& u, int wr, int fr, float (&pre)[8]) const {
#pragma unroll
        for (int i = 0; i < 8; ++i) pre[i] = *(const GAS float*)(rs + u.pm * 256 + wr * 64 + fr + (i >> 2) * 128 + (i & 3) * 16);
    }
    __device__ __forceinline__ void operator()(const f32x4 (&acc)[2][2][4][2], const Unit& u, int wr, int wc, int fr, int fq, const float (&pre)[8]) const {
        const int row0 = u.pm * 256 + wr * 64 + fr, col0 = u.pn * 128 + wc * 32 + 8 * fq;
#pragma unroll
        for (int ai = 0; ai < 2; ++ai)
#pragma unroll
            for (int m = 0; m < 4; ++m) {
                const float rsc = pre[ai * 4 + m];
                const f32x4 g0 = acc[ai][0][m][0] * rsc, g1 = acc[ai][0][m][1] * rsc, u0 = acc[ai][1][m][0] * rsc, u1 = acc[ai][1][m][1] * rsc;
                u32x4 w; w.x = cvt_pk_bf16(silu_mul(g0[0], u0[0]), silu_mul(g0[1], u0[1])); w.y = cvt_pk_bf16(silu_mul(g0[2], u0[2]), silu_mul(g0[3], u0[3]));
                w.z = cvt_pk_bf16(silu_mul(g1[0], u1[0]), silu_mul(g1[1], u1[1])); w.w = cvt_pk_bf16(silu_mul(g1[2], u1[2]), silu_mul(g1[3], u1[3]));
                *(GAS u32x4*)(O + (size_t)(row0 + ai * 128 + m * 16) * DFF + col0) = w; }
    }
};
template <int ACT, int STAT, int RS  > struct EpiStore {
    static constexpr bool PERM = true, AFTER_DRAIN = false, PREFETCH = (RS == 1); bf16_t* O; int ldc; int nsc; float scale; float* s1; float* s2; const float* rs;
    __device__ __forceinline__ void prefetch(const Unit& u, int wr, int fr, float (&pre)[8]) const {
#pragma unroll
        for (int i = 0; i < 8; ++i) pre[i] = *(const GAS float*)(rs + u.pm * 256 + wr * 64 + fr + (i >> 2) * 128 + (i & 3) * 16);
    }
    __device__ __forceinline__ void operator()(const f32x4 (&acc)[2][2][4][2], const Unit& u, int wr, int wc, int fr, int fq) const { const float none[8] = {1.f, 1.f, 1.f, 1.f, 1.f, 1.f, 1.f, 1.f}; (*this)(acc, u, wr, wc, fr, fq, none); }
    __device__ __forceinline__ void operator()(const f32x4 (&acc)[2][2][4][2], const Unit& u, int wr, int wc, int fr, int fq, const float (&pre)[8]) const {
        const int row0 = u.pm * 256 + wr * 64 + fr, col0 = u.pn * 256 + wc * 32 + 8 * fq;
        const float sc = (u.pn < nsc) ? scale : 1.f;
        float cs[2][2][4], cq[2][2][4];
#pragma unroll
        for (int a = 0; a < 2; ++a)
#pragma unroll
            for (int b = 0; b < 2; ++b)
#pragma unroll
                for (int e = 0; e < 4; ++e) { cs[a][b][e] = 0.f; cq[a][b][e] = 0.f; }
        f32x4 csc[2][2];
        if (RS == 2) {
#pragma unroll
            for (int bj = 0; bj < 2; ++bj) { csc[bj][0] = *(const GAS f32x4*)(rs + col0 + bj * 128); csc[bj][1] = *(const GAS f32x4*)(rs + col0 + bj * 128 + 4); }
        }
#pragma unroll
        for (int ai = 0; ai < 2; ++ai)
#pragma unroll
            for (int m = 0; m < 4; ++m) {
                const int row = row0 + ai * 128 + m * 16; bf16_t* rowp = O + (size_t)row * ldc + col0; float rs = 0.f;
                float rsc = 1.f; if (RS == 1) rsc = pre[ai * 4 + m];
#pragma unroll
                for (int bj = 0; bj < 2; ++bj) {
                    f32x4 v0 = acc[ai][bj][m][0], v1 = acc[ai][bj][m][1];
                    if (RS == 1) { v0 = v0 * rsc; v1 = v1 * rsc; }
                    if (RS == 2) { v0 = v0 * csc[bj][0]; v1 = v1 * csc[bj][1]; }
                    if (ACT == 1) { const f32x2 a = gelu_pk((f32x2){v0[0], v0[1]}), b = gelu_pk((f32x2){v0[2], v0[3]}), c = gelu_pk((f32x2){v1[0], v1[1]}), d = gelu_pk((f32x2){v1[2], v1[3]});
                        v0 = (f32x4){a.x, a.y, b.x, b.y}; v1 = (f32x4){c.x, c.y, d.x, d.y}; }
                    v0 = v0 * sc; v1 = v1 * sc;
                    if (STAT == 1) rs += (v0[0] * v0[0] + v0[1] * v0[1]) + (v0[2] * v0[2] + v0[3] * v0[3]) + (v1[0] * v1[0] + v1[1] * v1[1]) + (v1[2] * v1[2] + v1[3] * v1[3]);
                    if (STAT == 2) {
#pragma unroll
                        for (int e = 0; e < 4; ++e) { cs[bj][0][e] += v0[e]; cq[bj][0][e] += v0[e] * v0[e]; cs[bj][1][e] += v1[e]; cq[bj][1][e] += v1[e] * v1[e]; } }
                    u32x4 w; w.x = cvt_pk_bf16(v0[0], v0[1]); w.y = cvt_pk_bf16(v0[2], v0[3]); w.z = cvt_pk_bf16(v1[0], v1[1]); w.w = cvt_pk_bf16(v1[2], v1[3]);
                    *(GAS u32x4*)(rowp + bj * 128) = w; }
                if (STAT == 1) { rs += __shfl_xor(rs, 16); rs += __shfl_xor(rs, 32); if (fq == 0) *(GAS float*)(s1 + (size_t)row * 16 + u.pn * 4 + wc) = rs; }
            }
        if (STAT == 2) {
#pragma unroll
            for (int bj = 0; bj < 2; ++bj)
#pragma unroll
                for (int n = 0; n < 2; ++n)
#pragma unroll
                    for (int e = 0; e < 4; ++e) { float a = cs[bj][n][e], b = cq[bj][n][e];
#pragma unroll
                        for (int o = 1; o < 16; o <<= 1) { a += __shfl_xor(a, o); b += __shfl_xor(b, o); }
                        if (fr == 0) { const size_t slot = (size_t)(col0 + bj * 128 + 4 * n + e) * 8 + u.pm * 2 + wr; *(GAS float*)(s1 + slot) = a; *(GAS float*)(s2 + slot) = b; } }
        }
    }
};

#define LDS_WAIT() asm volatile("s_waitcnt lgkmcnt(0)" ::: "memory")
__device__ __forceinline__ float wave_sum(float v) {
#pragma unroll
    for (int o = 1; o < 64; o <<= 1) v += __shfl_xor(v, o);
    return v;
}
__device__ __forceinline__ float bf_lo(unsigned w) { return __uint_as_float(w << 16); }
__device__ __forceinline__ float bf_hi(unsigned w) { return __uint_as_float(w & 0xffff0000u); }

struct WItem { const float* W; const float* gk; bf16_t* WT; int K, N, drow0, k0, n0; };
__device__ __forceinline__ void item_load(const WItem& I, float (&v)[32], int lane) {
#pragma unroll
    for (int i = 0; i < 32; ++i) { const int kk = 2 * i + (lane >> 5); const float g = I.gk ? I.gk[I.k0 + kk] : 1.0f; v[i] = g * __builtin_nontemporal_load(I.W + (size_t)(I.k0 + kk) * I.N + I.n0 + (lane & 31)); }
}
__device__ __forceinline__ void item_store(const WItem& I, const float (&v)[32], LAS float* scr, int lane) {
#pragma unroll
    for (int i = 0; i < 32; ++i) { const int kk = 2 * i + (lane >> 5); scr[kk * 33 + (lane & 31)] = v[i]; }
    LDS_WAIT(); asm volatile("" ::: "memory");
    const int c = lane & 7;
#pragma unroll
    for (int j = 0; j < 4; ++j) { const int n = (lane >> 3) + 8 * j; const LAS float* s = scr + (8 * c) * 33 + n;
        u32x4 o; o.x = cvt_pk_bf16(s[0 * 33], s[1 * 33]); o.y = cvt_pk_bf16(s[2 * 33], s[3 * 33]); o.z = cvt_pk_bf16(s[4 * 33], s[5 * 33]); o.w = cvt_pk_bf16(s[6 * 33], s[7 * 33]);
        *(GAS u32x4*)(I.WT + (size_t)(I.drow0 + n) * I.K + I.k0 + 8 * c) = o; }
    LDS_WAIT(); asm volatile("" ::: "memory");
}

struct Ptrs {
    const float *x, *norm_pre, *norm_post, *wg, *wu, *wd, *a_win, *a_lng, *a_ws, *a_bs, *a_wout, *b_wqkv, *b_wo;
    float* out; unsigned char* ws;
};

__device__ __forceinline__ float lo_decode(unsigned hi16, int q4) { return __uint_as_float((hi16 << 16) + (unsigned)(q4 << 12)); }
__device__ __forceinline__ unsigned lo_encode(float h, unsigned hi16) {
    int d = (int)(__float_as_uint(h) - (hi16 << 16)); d = (d + 2048) >> 12; d = d > 7 ? 7 : d;
    return (unsigned)d & 0xfu;
}
struct FinStage { f32x4 v[2][2][2]; u32x4 hw[2][2]; unsigned lw[2][2]; u32x4 fw[2][2]; float sp[2]; };
template <bool HIN_F32>
__device__ __forceinline__ void fin_load(FinStage& S, const float* x, const bf16_t* HI, const unsigned char* LO, const bf16_t* f, const float* ss, int row0, int NGW, int lane) {
#pragma unroll
    for (int t = 0; t < 2; ++t) { const int row = row0 + t * NGW;
#pragma unroll
        for (int j = 0; j < 2; ++j) { const int idx = 512 * j + 8 * lane;
            if (HIN_F32) { S.v[t][j][0] = __builtin_nontemporal_load((const GAS f32x4*)(x + (size_t)row * DM + idx)); S.v[t][j][1] = __builtin_nontemporal_load((const GAS f32x4*)(x + (size_t)row * DM + idx + 4)); }
            else { S.hw[t][j] = __builtin_nontemporal_load((const GAS u32x4*)(HI + (size_t)row * DM + idx)); S.lw[t][j] = __builtin_nontemporal_load((const GAS unsigned*)(LO + (size_t)row * (DM / 2) + (idx >> 1))); }
            S.fw[t][j] = __builtin_nontemporal_load((const GAS u32x4*)(f + (size_t)row * DM + idx)); }
        S.sp[t] = *(const GAS float*)(ss + (size_t)row * 16 + (lane & 15)); }
}
template <bool HIN_F32, bool LAST>
__device__ __forceinline__ void fin_compute(FinStage& S, float* out, bf16_t* HI, unsigned char* LO, float* rs, const f32x4 (&gpv)[4], float coef, int row0, int NGW, int lane) {
#pragma unroll
    for (int t = 0; t < 2; ++t) { const int row = row0 + t * NGW; float s2 = 0.f;
        float tot = S.sp[t];
#pragma unroll
        for (int o = 1; o < 16; o <<= 1) tot += __shfl_xor(tot, o);
        const float r = coef * __builtin_amdgcn_rsqf(tot * (1.0f / DM) + RMS_EPS);
#pragma unroll
        for (int j = 0; j < 2; ++j) { const int idx = 512 * j + 8 * lane; float v[8];
            const u32x4 fw = S.fw[t][j];
            if (HIN_F32) {
#pragma unroll
                for (int e = 0; e < 8; ++e) v[e] = S.v[t][j][e >> 2][e & 3];
            } else { const u32x4 hw = S.hw[t][j]; const unsigned lw = S.lw[t][j];
#pragma unroll
                for (int e = 0; e < 8; ++e) { const unsigned w = hw[e >> 1]; v[e] = lo_decode((e & 1) ? (w >> 16) : (w & 0xffffu), (int)(lw << (28 - 4 * e)) >> 28); } }
#pragma unroll
            for (int e = 0; e < 8; ++e) { const unsigned w = fw[e >> 1]; v[e] += ((e & 1) ? bf_hi(w) : bf_lo(w)) * r * gpv[2 * j + (e >> 2)][e & 3]; }
            if (LAST) { __builtin_nontemporal_store((f32x4){v[0], v[1], v[2], v[3]}, (GAS f32x4*)(out + (size_t)row * DM + idx)); __builtin_nontemporal_store((f32x4){v[4], v[5], v[6], v[7]}, (GAS f32x4*)(out + (size_t)row * DM + idx + 4)); }
            else { u32x4 hw; hw.x = cvt_pk_bf16(v[0], v[1]); hw.y = cvt_pk_bf16(v[2], v[3]); hw.z = cvt_pk_bf16(v[4], v[5]); hw.w = cvt_pk_bf16(v[6], v[7]);
                unsigned lw = 0u;
#pragma unroll
                for (int e = 0; e < 8; ++e) { const unsigned w = hw[e >> 1]; lw |= lo_encode(v[e], (e & 1) ? (w >> 16) : (w & 0xffffu)) << (4 * e); s2 += v[e] * v[e]; }
                *(GAS u32x4*)(HI + (size_t)row * DM + idx) = hw; __builtin_nontemporal_store(lw, (GAS unsigned*)(LO + (size_t)row * (DM / 2) + (idx >> 1))); } }
        if (!LAST) { const float rn = __builtin_amdgcn_rsqf(wave_sum(s2) * (1.0f / DM) + RMS_EPS); if (lane == 0) *(GAS float*)(rs + row) = rn; } }
}
template <bool HIN_F32, bool LAST>
__device__ __forceinline__ void fin_phase(const float* x, float* out, bf16_t* HI, unsigned char* LO, float* rs, const bf16_t* f, const float* ss, const float* gpost, float coef, int gw, int NGW, int rend, int lane) {
    f32x4 gpv[4];
#pragma unroll
    for (int j = 0; j < 4; ++j) gpv[j] = *(const GAS f32x4*)(gpost + 512 * (j >> 1) + 8 * lane + 4 * (j & 1));
    FinStage S[3];
    fin_load<HIN_F32>(S[0], x, HI, LO, f, ss, gw, NGW, lane);
    if (gw + 2 * NGW < rend) fin_load<HIN_F32>(S[1], x, HI, LO, f, ss, gw + 2 * NGW, NGW, lane);
    for (int base = gw; base < rend; base += 6 * NGW) {
#pragma unroll
        for (int u = 0; u < 3; ++u) {
            const int rowc = base + 2 * NGW * u, rowl = rowc + 4 * NGW;
            if (rowl < rend) fin_load<HIN_F32>(S[(u + 2) % 3], x, HI, LO, f, ss, rowl, NGW, lane);
            if (rowc < rend) fin_compute<HIN_F32, LAST>(S[u], out, HI, LO, rs, gpv, coef, rowc, NGW, lane);
        }
    }
}
__device__ __forceinline__ void x_phase(const float* x, bf16_t* HI, float* rs, int gw, int NGW, int lane) {
    for (int row0 = gw; row0 < TOK; row0 += 4 * NGW) {
        f32x4 v[4][4];
#pragma unroll
        for (int t = 0; t < 4; ++t) { const int row = row0 + t * NGW;
#pragma unroll
            for (int j = 0; j < 4; ++j) v[t][j] = (row < TOK) ? __builtin_nontemporal_load((const GAS f32x4*)(x + (size_t)row * DM + 256 * j + 4 * lane)) : (f32x4){0.f, 0.f, 0.f, 0.f}; }
#pragma unroll
        for (int t = 0; t < 4; ++t) { const int row = row0 + t * NGW; float s2 = 0.f;
            if (row < TOK) {
#pragma unroll
                for (int j = 0; j < 4; ++j) { s2 += (v[t][j][0] * v[t][j][0] + v[t][j][1] * v[t][j][1]) + (v[t][j][2] * v[t][j][2] + v[t][j][3] * v[t][j][3]);
                    u32x2 hw; hw.x = cvt_pk_bf16(v[t][j][0], v[t][j][1]); hw.y = cvt_pk_bf16(v[t][j][2], v[t][j][3]); *(GAS u32x2*)(HI + (size_t)row * DM + 256 * j + 4 * lane) = hw; }
                const float rn = __builtin_amdgcn_rsqf(wave_sum(s2) * (1.0f / DM) + RMS_EPS); if (lane == 0) *(GAS float*)(rs + row) = rn; } }
    }
}
__device__ __forceinline__ WItem witem(const Ptrs& P, int it) {
    bf16_t* WB = (bf16_t*)(P.ws + WS_W);
    constexpr int I_FFN = (DM / 64) * (DFF / 32);
    constexpr int N_FFN = 8 * 3 * I_FFN;
    constexpr int I_AIN = 16 * 64, I_AOUT = 16 * 32, N_A = 2 * (I_AIN + I_AOUT);
    constexpr int I_BQKV = 16 * 96, I_BO = 16 * 32;
    WItem I; I.gk = nullptr;
    if (it < N_FFN) {
        const int q = it / I_FFN, r = it % I_FFN, li = q / 3, which = q % 3;
        bf16_t* base = WB + (size_t)li * W_FFN_STRIDE;
        if (which < 2) {
            const int nblk = DFF / 32, kb = r / nblk, nb = r % nblk, n0 = 32 * nb;
            I.W = (which == 0 ? P.wg : P.wu) + (size_t)li * DM * DFF; I.K = DM; I.N = DFF; I.WT = base + W_GU; I.drow0 = 256 * (n0 >> 7) + 128 * which + (n0 & 127); I.k0 = 64 * kb; I.n0 = n0;
            I.gk = P.norm_pre + (size_t)((li >> 1) * 3 + (li & 1) * 2) * DM;
        } else {
            const int nblk = DM / 32, kb = r / nblk, nb = r % nblk, n0 = 32 * nb;
            I.W = P.wd + (size_t)li * DFF * DM; I.K = DFF; I.N = DM; I.WT = base + W_DN; I.drow0 = n0; I.k0 = 64 * kb; I.n0 = n0;
        }
    } else if (it < N_FFN + N_A) {
        const int i2 = it - N_FFN, la = i2 / (I_AIN + I_AOUT), r = i2 % (I_AIN + I_AOUT);
        bf16_t* base = WB + W_A0 + (size_t)la * W_A_STRIDE;
        if (r < I_AIN) { const int nblk = 64, kb = r / nblk, nb = r % nblk; I.W = P.a_win + (size_t)la * DM * 2 * DM; I.K = DM; I.N = 2 * DM; I.WT = base + W_AIN; I.drow0 = 32 * nb; I.k0 = 64 * kb; I.n0 = 32 * nb; I.gk = P.norm_pre + (size_t)((2 * la) * 3 + 1) * DM; }
        else { const int r2 = r - I_AIN, nblk = 32, kb = r2 / nblk, nb = r2 % nblk; I.W = P.a_wout + (size_t)la * DM * DM; I.K = DM; I.N = DM; I.WT = base + W_AOUT; I.drow0 = 32 * nb; I.k0 = 64 * kb; I.n0 = 32 * nb; }
    } else {
        const int i3 = it - N_FFN - N_A, lb = i3 / (I_BQKV + I_BO), r = i3 % (I_BQKV + I_BO);
        bf16_t* base = WB + W_B0 + (size_t)lb * W_B_STRIDE;
        if (r < I_BQKV) { const int nblk = 96, kb = r / nblk, nb = r % nblk; I.W = P.b_wqkv + (size_t)lb * DM * 3 * DM; I.K = DM; I.N = 3 * DM; I.WT = base + W_BQKV; I.drow0 = 32 * nb; I.k0 = 64 * kb; I.n0 = 32 * nb; I.gk = P.norm_pre + (size_t)((2 * lb + 1) * 3 + 1) * DM; }
        else { const int r2 = r - I_BQKV, nblk = 32, kb = r2 / nblk, nb = r2 % nblk; I.W = P.b_wo + (size_t)lb * DM * DM; I.K = DM; I.N = DM; I.WT = base + W_BO; I.drow0 = 32 * nb; I.k0 = 64 * kb; I.n0 = 32 * nb; }
    }
    return I;
}
__device__ __forceinline__ void prologue_phase(const Ptrs& P, LAS unsigned char* lds, int gw, int NGW, int wave, int lane) {
    LAS float* scr = (LAS float*)(lds + wave * 16384);
    constexpr int NITEMS = 8 * 3 * ((DM / 64) * (DFF / 32)) + 2 * (16 * 64 + 16 * 32) + 2 * (16 * 96 + 16 * 32);
    float va[32], vb[32];
    if (gw < NITEMS) { WItem Ia = witem(P, gw); item_load(Ia, va, lane);
        for (int it = gw; it < NITEMS; it += 2 * NGW) {
            const int i1 = it + NGW, i2 = it + 2 * NGW; WItem Ib = Ia;
            if (i1 < NITEMS) { Ib = witem(P, i1); item_load(Ib, vb, lane); }
            item_store(Ia, va, scr, lane);
            if (i1 < NITEMS) { if (i2 < NITEMS) { Ia = witem(P, i2); item_load(Ia, va, lane); }
                item_store(Ib, vb, scr, lane); }
        } }
    x_phase(P.x, (bf16_t*)(P.ws + WS_HN), (float*)(P.ws + WS_RS), gw, NGW, lane);
}

__device__ __forceinline__ int rowmap32(int m) { return 16 * ((m >> 2) & 1) + 4 * (m >> 3) + (m & 3); }
__device__ __forceinline__ bf16x8 lds_frag(const LAS unsigned char* p) { return *(const LAS bf16x8*)p; }

__device__ __forceinline__ void spatial_phase(LAS unsigned char* lds, const bf16_t* U, const bf16_t* VT, const float* vsum, const float* vsq, const float* lng, const float* Ws, const float* bs, bf16_t* Y, int c0, int G, int nunits, int ldt) {
    int tid_ = threadIdx.x; asm volatile("" : "+v"(tid_));
    const int tid = tid_, lane = tid & 63, wid = __builtin_amdgcn_readfirstlane(tid >> 6), q = lane & 31, hh = lane >> 5;
    LAS unsigned char* Wl = lds; LAS unsigned char* Vl = lds + 32768; LAS float* st = (LAS float*)(lds + 98304);
    const bool wfixed = (G & 7) == 0;
    const int r4 = tid >> 2, sbase = (tid & 3) * 32, vswz = (r4 & 7) | (((r4 >> 4) & 1) << 3);
    const int ct = wid & 3, tp = wid >> 2, arow = ct * 32 + rowmap32(q), aswz = (arow & 7) | (((arow >> 4) & 1) << 3);
#define SP_STATS(unit_, buf_) do { if (tid < 128) { const int tok_ = ((unit_) >> 3) * 128 + tid; const GAS f32x4* p1 = (const GAS f32x4*)(vsum + (size_t)tok_ * 8); const GAS f32x4* p2 = (const GAS f32x4*)(vsq + (size_t)tok_ * 8); \
        const f32x4 a = p1[0], b = p1[1], c = p2[0], d = p2[1]; \
        const float mean = (((a[0] + a[1]) + (a[2] + a[3])) + ((b[0] + b[1]) + (b[2] + b[3]))) * (1.0f / DM), var = (((c[0] + c[1]) + (c[2] + c[3])) + ((d[0] + d[1]) + (d[2] + d[3]))) * (1.0f / DM) - mean * mean; \
        st[(buf_) * 256 + tid] = mean; st[(buf_) * 256 + 128 + tid] = __builtin_amdgcn_rsqf(fmaxf(var, 0.f) + LN_EPS); } } while (0)
#define SP_WTILE(g_) do { const float* wp = Ws + ((size_t)(g_) * 128 + r4) * 128 + sbase; \
        _Pragma("unroll") for (int c = 0; c < 4; ++c) { const f32x4 a = *(const GAS f32x4*)(wp + 8 * c), b = *(const GAS f32x4*)(wp + 8 * c + 4); const int s0 = sbase + 8 * c; float w[8] = {a[0], a[1], a[2], a[3], b[0], b[1], b[2], b[3]}; \
            _Pragma("unroll") for (int j = 0; j < 8; ++j) w[j] = (s0 + j <= r4) ? w[j] : 0.f; \
            u32x4 o; o.x = cvt_pk_bf16(w[0], w[1]); o.y = cvt_pk_bf16(w[2], w[3]); o.z = cvt_pk_bf16(w[4], w[5]); o.w = cvt_pk_bf16(w[6], w[7]); \
            const int chunk = (sbase >> 3) + c; *(LAS u32x4*)(Wl + r4 * 256 + ((chunk ^ (r4 & 15)) << 4)) = o; } } while (0)
#define SP_VLOAD(unit_, raw_) do { const bf16_t* vp = VT + (size_t)(((unit_) & 7) * 128 + r4) * ldt + ((unit_) >> 3) * 128 + sbase; \
        _Pragma("unroll") for (int c = 0; c < 4; ++c) raw_[c] = *(const GAS u32x4*)(vp + 8 * c); } while (0)
#define SP_VSTORE(unit_, buf_, raw_) do { const float gl = lng[((unit_) & 7) * 128 + r4]; const LAS float* mu = st + (buf_) * 256; \
        _Pragma("unroll") for (int c = 0; c < 4; ++c) { const u32x4 raw = raw_[c]; const int s0 = sbase + 8 * c; float v[8] = {bf_lo(raw.x), bf_hi(raw.x), bf_lo(raw.y), bf_hi(raw.y), bf_lo(raw.z), bf_hi(raw.z), bf_lo(raw.w), bf_hi(raw.w)}; \
            _Pragma("unroll") for (int j = 0; j < 8; ++j) v[j] = (v[j] - mu[s0 + j]) * mu[128 + s0 + j] * gl; \
            u32x4 o; o.x = cvt_pk_bf16(v[0], v[1]); o.y = cvt_pk_bf16(v[2], v[3]); o.z = cvt_pk_bf16(v[4], v[5]); o.w = cvt_pk_bf16(v[6], v[7]); \
            const int chunk = (sbase >> 3) + c; *(LAS u32x4*)(Vl + (buf_) * 32768 + r4 * 256 + ((chunk ^ vswz) << 4)) = o; } } while (0)
    if (c0 >= nunits) return;
    u32x4 vraw[4];
    SP_WTILE(c0 & 7); SP_STATS(c0, 0); SP_VLOAD(c0, vraw);
    __syncthreads();
    SP_VSTORE(c0, 0, vraw);
    if (c0 + G < nunits) SP_STATS(c0 + G, 1);
    __syncthreads();
    int it = 0;
    for (int unit = c0; unit < nunits; unit += G, ++it) {
        const int cur = it & 1, nxt = cur ^ 1, un = unit + G, un2 = unit + 2 * G;
        const int bc = unit >> 3, g = unit & 7, tok0 = bc * 128, ch0 = g * 128;
        if (un < nunits) SP_VLOAD(un, vraw);
        const LAS unsigned char* Vc = Vl + cur * 32768;
#pragma unroll
        for (int ti = 0; ti < 2; ++ti) {
            const int tt = 2 * tp + ti, brow = tt * 32 + q, bswz = brow & 15, nks = 2 * (tt + 1);
            const float bias = bs[g * 128 + tt * 32 + q];
            const size_t off = (size_t)(tok0 + tt * 32 + q) * DM + ch0 + ct * 32 + 16 * hh;
            const u32x4 ua = *(const GAS u32x4*)(U + off), ub = *(const GAS u32x4*)(U + off + 8);
            f32x16 C;
#pragma unroll
            for (int r = 0; r < 16; ++r) C[r] = 0.f;
            for (int ks = 0; ks < nks; ++ks) { const int chunk = 2 * ks + hh;
                const bf16x8 A = lds_frag(Vc + arow * 256 + ((chunk ^ aswz) << 4)), B = lds_frag(Wl + brow * 256 + ((chunk ^ bswz) << 4));
                C = __builtin_amdgcn_mfma_f32_32x32x16_bf16(A, B, C, 0, 0, 0); }
            u32x4 oa, ob;
            oa.x = cvt_pk_bf16(bf_lo(ua.x) * (C[0] + bias), bf_hi(ua.x) * (C[1] + bias)); oa.y = cvt_pk_bf16(bf_lo(ua.y) * (C[2] + bias), bf_hi(ua.y) * (C[3] + bias));
            oa.z = cvt_pk_bf16(bf_lo(ua.z) * (C[4] + bias), bf_hi(ua.z) * (C[5] + bias)); oa.w = cvt_pk_bf16(bf_lo(ua.w) * (C[6] + bias), bf_hi(ua.w) * (C[7] + bias));
            ob.x = cvt_pk_bf16(bf_lo(ub.x) * (C[8] + bias), bf_hi(ub.x) * (C[9] + bias)); ob.y = cvt_pk_bf16(bf_lo(ub.y) * (C[10] + bias), bf_hi(ub.y) * (C[11] + bias));
            ob.z = cvt_pk_bf16(bf_lo(ub.z) * (C[12] + bias), bf_hi(ub.z) * (C[13] + bias)); ob.w = cvt_pk_bf16(bf_lo(ub.w) * (C[14] + bias), bf_hi(ub.w) * (C[15] + bias));
            *(GAS u32x4*)(Y + off) = oa; *(GAS u32x4*)(Y + off + 8) = ob;
        }
        if (un < nunits) {
            if (!wfixed) { __syncthreads(); SP_WTILE(un & 7); }
            SP_VSTORE(un, nxt, vraw);
            if (un2 < nunits) SP_STATS(un2, cur);
        }
        __syncthreads();
    }
#undef SP_STATS
#undef SP_WTILE
#undef SP_VLOAD
#undef SP_VSTORE
}

__device__ __forceinline__ int swz64(int row) { return ((row >> 1) & 3) | (((row >> 4) & 1) << 2); }
__device__ __forceinline__ void attn_phase(LAS unsigned char* lds, const bf16_t* QK, const bf16_t* Vt, bf16_t* O, int c0, int G, int bhend, int ldt) {
    int tid_ = threadIdx.x; asm volatile("" : "+v"(tid_));
    const int tid = tid_, lane = tid & 63, wid = __builtin_amdgcn_readfirstlane(tid >> 6), q = lane & 31, hh = lane >> 5;
    const int srow = tid >> 3, sc16 = tid & 7, soff = srow * 128 + ((sc16 ^ swz64(srow)) << 4);
    const int arow = rowmap32(q), sw = swz64(arow);
    LAS unsigned* flags = (LAS unsigned*)(lds + 32768);
    for (int bh = c0; bh < bhend; bh += G) {
        const int b = bh >> 4, h = bh & 15; const size_t tokbase = (size_t)b * SEQ;
        const bf16_t* kg = QK + (tokbase + srow) * 2048 + 1024 + h * 64 + sc16 * 8;
        const bf16_t* vg = Vt + (size_t)(h * 64 + srow) * ldt + tokbase + sc16 * 8;
        for (int qb = 7; qb >= 0; --qb) {
            const int q0 = qb * 256 + 32 * wid, nt = 4 * (qb + 1);
            bf16x8 qf[4];
            { const bf16_t* qp = QK + (tokbase + q0 + q) * 2048 + h * 64 + 8 * hh;
#pragma unroll
              for (int ds = 0; ds < 4; ++ds) qf[ds] = *(const GAS bf16x8*)(qp + 16 * ds); }
            float carry = 1.f; f32x16 o0, o1; bool alive = true;
#pragma unroll
            for (int r = 0; r < 16; ++r) { o0[r] = 0.f; o1[r] = 0.f; }
            u32x4 kreg = *(const GAS u32x4*)(kg + (size_t)(64 * (nt - 1)) * 2048), vreg = *(const GAS u32x4*)(vg + 64 * (nt - 1));
            u32x4 kA = *(const GAS u32x4*)(kg + (size_t)(64 * (nt - 2)) * 2048), vA = *(const GAS u32x4*)(vg + 64 * (nt - 2));
            *(LAS u32x4*)(lds + soff) = kreg; *(LAS u32x4*)(lds + 8192 + soff) = vreg;
            __syncthreads();
            bool fin = false;
#define ATT_ITER(i, KL, VL, KW, VW) { \
                const int kt = nt - 1 - i; LAS unsigned char* cur = lds + (i & 1) * 16384; LAS unsigned char* nxt = lds + ((i & 1) ^ 1) * 16384; \
                if (i + 2 < nt) { KL = *(const GAS u32x4*)(kg + (size_t)(64 * (kt - 2)) * 2048); VL = *(const GAS u32x4*)(vg + 64 * (kt - 2)); } \
                if (alive && 64 * kt <= q0 + 30) { \
_Pragma("unroll") \
                    for (int sub = 1; sub >= 0; --sub) { \
                        const int ksub = 64 * kt + 32 * sub; \
                        if (ksub <= q0 + 30) { \
                            f32x16 S; \
_Pragma("unroll") \
                            for (int r = 0; r < 16; ++r) S[r] = 0.f; \
_Pragma("unroll") \
                            for (int ds = 0; ds < 4; ++ds) S = __builtin_amdgcn_mfma_f32_32x32x16_bf16(lds_frag(cur + (32 * sub + arow) * 128 + (((2 * ds + hh) ^ sw) << 4)), qf[ds], S, 0, 0, 0); \
                            float e[16]; \
                            if (ksub + 31 >= q0) { const int kq = (q0 + q) - (ksub + 16 * hh); \
_Pragma("unroll") \
                                for (int r = 0; r < 16; ++r) { const float x = __builtin_amdgcn_exp2f(__builtin_fminf(S[r], 15.0f)); e[r] = (r >= kq) ? 0.f : x; } \
                            } else { \
_Pragma("unroll") \
                                for (int r = 0; r < 16; ++r) e[r] = __builtin_amdgcn_exp2f(__builtin_fminf(S[r], 15.0f)); } \
                            float PL = 1.f, PH = 1.f, al[8], ah[8]; \
_Pragma("unroll") \
                            for (int r = 0; r < 8; ++r) { al[r] = e[r] * PL; PL = __builtin_fmaf(PL, e[r], PL); ah[r] = e[r + 8] * PH; PH = __builtin_fmaf(PH, e[r + 8], PH); } \
                            const float iL = __builtin_amdgcn_rcpf(PL), iH = __builtin_amdgcn_rcpf(PH), s = iL * iH; \
                            const float tp = __shfl_xor(s, 32); \
                            const float mult = hh ? carry : carry * tp; \
                            carry = carry * s * tp; \
                            const float cH = iH * mult, cL = iL * cH; \
                            u32x4 p0, p1; \
                            p0.x = cvt_pk_bf16(al[0] * cL, al[1] * cL); p0.y = cvt_pk_bf16(al[2] * cL, al[3] * cL); p0.z = cvt_pk_bf16(al[4] * cL, al[5] * cL); p0.w = cvt_pk_bf16(al[6] * cL, al[7] * cL); \
                            p1.x = cvt_pk_bf16(ah[0] * cH, ah[1] * cH); p1.y = cvt_pk_bf16(ah[2] * cH, ah[3] * cH); p1.z = cvt_pk_bf16(ah[4] * cH, ah[5] * cH); p1.w = cvt_pk_bf16(ah[6] * cH, ah[7] * cH); \
                            const bf16x8 pb0 = __builtin_bit_cast(bf16x8, p0), pb1 = __builtin_bit_cast(bf16x8, p1); \
                            const LAS unsigned char* vb = cur + 8192 + arow * 128; \
                            o0 = __builtin_amdgcn_mfma_f32_32x32x16_bf16(lds_frag(vb + (((4 * sub + 2 * hh) ^ sw) << 4)), pb0, o0, 0, 0, 0); \
                            o0 = __builtin_amdgcn_mfma_f32_32x32x16_bf16(lds_frag(vb + (((4 * sub + 2 * hh + 1) ^ sw) << 4)), pb1, o0, 0, 0, 0); \
                            o1 = __builtin_amdgcn_mfma_f32_32x32x16_bf16(lds_frag(vb + 4096 + (((4 * sub + 2 * hh) ^ sw) << 4)), pb0, o1, 0, 0, 0); \
                            o1 = __builtin_amdgcn_mfma_f32_32x32x16_bf16(lds_frag(vb + 4096 + (((4 * sub + 2 * hh + 1) ^ sw) << 4)), pb1, o1, 0, 0, 0); \
                        } \
                    } \
                } \
                alive = __builtin_amdgcn_ballot_w64(carry != 0.f) != 0ull; \
                if (lane == 0) flags[(i & 1) * 8 + wid] = alive ? 1u : 0u; \
                if (i + 1 < nt) { *(LAS u32x4*)(nxt + soff) = KW; *(LAS u32x4*)(nxt + 8192 + soff) = VW; } \
                __syncthreads(); \
                { const LAS u32x4* fp = (const LAS u32x4*)(flags + (i & 1) * 8); const u32x4 fa = fp[0], fb = fp[1]; \
                  if (((fa.x | fa.y) | (fa.z | fa.w) | (fb.x | fb.y) | (fb.z | fb.w)) == 0u) { fin = true; } } \
            }
            for (int i2 = 0; i2 < nt && !fin; i2 += 2) {
                ATT_ITER(i2, kreg, vreg, kA, vA)
                if (fin) break;
                ATT_ITER((i2 + 1), kA, vA, kreg, vreg)
            }
#undef ATT_ITER
            bf16_t* op = O + (tokbase + q0 + q) * DM + h * 64 + 16 * hh;
            u32x4 w;
            w.x = cvt_pk_bf16(o0[0], o0[1]); w.y = cvt_pk_bf16(o0[2], o0[3]); w.z = cvt_pk_bf16(o0[4], o0[5]); w.w = cvt_pk_bf16(o0[6], o0[7]); *(GAS u32x4*)(op) = w;
            w.x = cvt_pk_bf16(o0[8], o0[9]); w.y = cvt_pk_bf16(o0[10], o0[11]); w.z = cvt_pk_bf16(o0[12], o0[13]); w.w = cvt_pk_bf16(o0[14], o0[15]); *(GAS u32x4*)(op + 8) = w;
            w.x = cvt_pk_bf16(o1[0], o1[1]); w.y = cvt_pk_bf16(o1[2], o1[3]); w.z = cvt_pk_bf16(o1[4], o1[5]); w.w = cvt_pk_bf16(o1[6], o1[7]); *(GAS u32x4*)(op + 32) = w;
            w.x = cvt_pk_bf16(o1[8], o1[9]); w.y = cvt_pk_bf16(o1[10], o1[11]); w.z = cvt_pk_bf16(o1[12], o1[13]); w.w = cvt_pk_bf16(o1[14], o1[15]); *(GAS u32x4*)(op + 40) = w;
        }
    }
}

#define XB_TMO      128
#define XB_XCNT(j)  (256  + 64 * (j))
#define XB_XSUB(j)  (1280 + 64 * (j))
#define XB_XGEN(j)  (2304 + 64 * (j))
#define XB_TOP      3328
#define XB_TOPGEN   3392
#define XCD_BAR_WORDS 3456
#define XB_SPIN_CAP (1u << 18)

__device__ __forceinline__ unsigned xb_ld(unsigned* p)              { return __hip_atomic_load(p, __ATOMIC_RELAXED, __HIP_MEMORY_SCOPE_AGENT); }
__device__ __forceinline__ unsigned xb_add(unsigned* p, unsigned v) { return __hip_atomic_fetch_add(p, v, __ATOMIC_RELAXED, __HIP_MEMORY_SCOPE_AGENT); }
__device__ __forceinline__ unsigned xb_xcc_id() { return (unsigned)__builtin_amdgcn_s_getreg((3 << 11) | 20) & 0xFu; }
#define XB_SPIN(cond, bar) do { unsigned _sp = 0; while (cond) { __builtin_amdgcn_s_sleep(1); \
    if ((++_sp & 255u) == 0u) { if (xb_ld(&(bar)[XB_TMO])) break; if (_sp > XB_SPIN_CAP) { atomicAdd(&(bar)[XB_TMO], 1u); break; } } } } while (0)

struct XcdBarrier {
    unsigned* bar; unsigned x;
    volatile LAS unsigned* st;
};

__device__ __forceinline__ XcdBarrier xcd_barrier_post(unsigned* bar, volatile LAS unsigned* st) {
    XcdBarrier b; b.bar = bar; b.x = xb_xcc_id(); b.st = st;
    if (threadIdx.x == 0) (void)xb_add(&bar[XB_XCNT(b.x)], 1u);
    return b;
}
__device__ __forceinline__ void xcd_barrier_complete(unsigned* bar, unsigned x, unsigned& nloc, unsigned& nx) {
    const unsigned G = gridDim.x * gridDim.y * gridDim.z;
    unsigned sum, cnt, mine, sp = 0u;
    for (;;) {
        sum = 0u; cnt = 0u; mine = 0u;
#pragma unroll
        for (unsigned j = 0; j < 16; ++j) { const unsigned c = xb_ld(&bar[XB_XCNT(j)]); sum += c; cnt += (c > 0u) ? 1u : 0u; mine = (j == x) ? c : mine; }
        if (sum == G) break;
        __builtin_amdgcn_s_sleep(1);
        if ((++sp & 255u) == 0u) { if (xb_ld(&bar[XB_TMO])) break; if (sp > XB_SPIN_CAP) { atomicAdd(&bar[XB_TMO], 1u); break; } }
    }
    nloc = mine > 0u ? mine : 1u; nx = cnt > 0u ? cnt : 1u;
}

__device__ __forceinline__ void xcd_barrier(const XcdBarrier& b) {
    asm volatile("s_waitcnt vmcnt(0)" ::: "memory");
    __syncthreads();
    if (threadIdx.x == 0) {
        unsigned* bar = b.bar;
        __builtin_amdgcn_s_waitcnt(0);
        unsigned nloc = b.st[0], nx = b.st[1];
        if (nloc == 0u) { xcd_barrier_complete(bar, b.x, nloc, nx); b.st[0] = nloc; b.st[1] = nx; }
        const unsigned old = xb_add(&bar[XB_XSUB(b.x)], 1u);
        const unsigned gen = old / nloc;
        if (old + 1u == (gen + 1u) * nloc) {
            __builtin_amdgcn_fence(__ATOMIC_RELEASE, "agent");
            asm volatile("s_waitcnt vmcnt(0)" ::: "memory");
            const unsigned og = xb_add(&bar[XB_TOP], 1u);
            const unsigned tg = og / nx;
            if (og + 1u == (tg + 1u) * nx) xb_add(&bar[XB_TOPGEN], 1u);
            else XB_SPIN(xb_ld(&bar[XB_TOPGEN]) == tg, bar);
            __builtin_amdgcn_fence(__ATOMIC_ACQUIRE, "agent");
            xb_add(&bar[XB_XGEN(b.x)], 1u);
            asm volatile("s_waitcnt vmcnt(0)" ::: "memory");
        } else {
            XB_SPIN(xb_ld(&bar[XB_XGEN(b.x)]) == gen, bar);
            __builtin_amdgcn_fence(__ATOMIC_ACQUIRE, "agent");
            asm volatile("s_waitcnt vmcnt(0)" ::: "memory");
        }
    }
    __syncthreads();
}


__device__ __forceinline__ void xcc_barrier(unsigned* bar, unsigned x, unsigned nloc) {
    asm volatile("s_waitcnt vmcnt(0)" ::: "memory");
    __syncthreads();
    if (threadIdx.x == 0) {
        const unsigned old = xb_add(&bar[4096 + 64 * x], 1u), gen = old / nloc;
        const bool last = (old + 1u == (gen + 1u) * nloc);
        if (last) xb_add(&bar[4608 + 64 * x], 1u);
        __builtin_amdgcn_fence(__ATOMIC_ACQUIRE, "agent");
        if (!last) XB_SPIN(xb_ld(&bar[4608 + 64 * x]) == gen, bar);
        asm volatile("s_waitcnt vmcnt(0)" ::: "memory");
    }
    __syncthreads();
}

#ifndef MK_MULTI
#define MK_MULTI 0
#endif
constexpr int N_PHASES = 1 + DEPTH * 10;
#ifndef PMASK
#define PMASK 0x1ff
#endif
struct Args { Ptrs p; int ph_lo, ph_hi; };
static_assert(sizeof(Args) == 15 * 8 + 8, "Args has no padding");

template <class Epi> __device__ __forceinline__ void run_gemm(LAS unsigned char* lds, const bf16_t* A, const bf16_t* Bt, int M, int N, int K, const Epi& E, int c, int i0 = 0, int ni = 1 << 30) {
    pg8::Gemm g{A, Bt, M, N, K}; pg8::StaticOrder S; S.init(M, N, (int)gridDim.x, c); S.i0 = i0; S.ni = ni;
    pg8::gemm_phase<Epi, pg8::StaticOrder, true, true>(lds, g, S, E);
}

__global__ void __launch_bounds__(NTHREADS, 2) fwd_kernel(Args a) {
    extern __shared__ __attribute__((aligned(16))) unsigned char lds_raw[];
    LAS unsigned char* lds = (LAS unsigned char*)lds_raw;
    cg::grid_group grid = cg::this_grid();
    volatile LAS unsigned* bst = (volatile LAS unsigned*)(lds + 131072 + 64);
    if (threadIdx.x < 2) bst[threadIdx.x] = 0u;
    __syncthreads();
    XcdBarrier xbar = xcd_barrier_post((unsigned*)(a.p.ws + WS_BAR), bst);
    unsigned* barw = (unsigned*)(a.p.ws + WS_BAR);
    unsigned* tick = barw + 3520;
    if (threadIdx.x == 0) { const unsigned x = xbar.x; bst[2] = (x < 8u) ? __hip_atomic_fetch_add(tick + 64 * x, 1u, __ATOMIC_RELAXED, __HIP_MEMORY_SCOPE_AGENT) : 0u; }
    __syncthreads();
    const int my_ticket = (int)bst[2];
    int vc = (int)blockIdx.x; bool local_ok = false;
    const bool xl = (gridDim.x == 256);
#define AS_GLOBAL(T, p) ((T*)(__attribute__((address_space(1))) T*)(p))
    Ptrs P;
    P.x = AS_GLOBAL(const float, a.p.x); P.norm_pre = AS_GLOBAL(const float, a.p.norm_pre); P.norm_post = AS_GLOBAL(const float, a.p.norm_post); P.wg = AS_GLOBAL(const float, a.p.wg); P.wu = AS_GLOBAL(const float, a.p.wu);
    P.wd = AS_GLOBAL(const float, a.p.wd); P.a_win = AS_GLOBAL(const float, a.p.a_win); P.a_lng = AS_GLOBAL(const float, a.p.a_lng); P.a_ws = AS_GLOBAL(const float, a.p.a_ws); P.a_bs = AS_GLOBAL(const float, a.p.a_bs);
    P.a_wout = AS_GLOBAL(const float, a.p.a_wout); P.b_wqkv = AS_GLOBAL(const float, a.p.b_wqkv); P.b_wo = AS_GLOBAL(const float, a.p.b_wo); P.out = AS_GLOBAL(float, a.p.out); P.ws = AS_GLOBAL(unsigned char, a.p.ws);
    for (int ph = a.ph_lo; ph < a.ph_hi; ++ph) {
        int tid_ = threadIdx.x; asm volatile("" : "+v"(tid_));
        const int tid = tid_, lane = tid & 63, wave = __builtin_amdgcn_readfirstlane(tid >> 6), G = gridDim.x;
        const int gw = blockIdx.x * NWAVES + wave, NGW = G * NWAVES;
        const int xx = vc & 7, jj = vc >> 3;
        unsigned char* ws_ = P.ws; asm volatile("" : "+s"(ws_)); unsigned char* ws = AS_GLOBAL(unsigned char, ws_);
        bf16_t* WB = (bf16_t*)(ws + WS_W); bf16_t* HN = (bf16_t*)(ws + WS_HN); bf16_t* FB = (bf16_t*)(ws + WS_F); bf16_t* BIG = (bf16_t*)(ws + WS_BIG);
        const size_t xtok = xl ? (size_t)8192 * xx : 0; const int ldt = xl ? 8192 : TOK;
        bf16_t* RB = xl ? BIG + (size_t)xx * (24 * MiB) : BIG;
        bf16_t* ACT = RB - xtok * DFF; bf16_t* UB = RB - xtok * DM; bf16_t* VTB = RB + (xl ? (size_t)8192 * DM : (size_t)TOK * DM) - xtok;
        bf16_t* QKB = RB - xtok * 2 * DM; bf16_t* VtB = RB + (xl ? (size_t)8192 * 2 * DM : (size_t)TOK * 2 * DM) - xtok;
        float* ss = (float*)(ws + WS_SS); float* vsum = (float*)(ws + WS_VSUM); float* vsq = (float*)(ws + WS_VSQ); float* rs = (float*)(ws + WS_RS); unsigned char* LO = ws + WS_LO;
        bf16_t* YB = (bf16_t*)P.out;
        if (ph == 0) { if constexpr (PMASK & 1) prologue_phase(P, lds, gw, NGW, wave, lane); }
        else {
            const int L = (ph - 1) / 10, k = (ph - 1) % 10, mix = L & 1, lm = L >> 1;
            if (k == 0 || k == 7) {
                const int li = 2 * L + (k == 7);
                EpiSwiGLU E{ACT, rs};
                if constexpr (PMASK & 2) run_gemm(lds, HN, WB + (size_t)li * W_FFN_STRIDE + W_GU, TOK, 2 * DFF, DM, E, vc, 0, xl ? 11 : (1 << 30));
            } else if (k == 1 || k == 8 || k == 5) {
                const bf16_t* A; const bf16_t* Bt; int K;
                if (k == 5) { A = YB; K = DM; Bt = mix ? WB + W_B0 + (size_t)lm * W_B_STRIDE + W_BO : WB + W_A0 + (size_t)lm * W_A_STRIDE + W_AOUT; }
                else { const int li = 2 * L + (k == 8); A = ACT; K = DFF; Bt = WB + (size_t)li * W_FFN_STRIDE + W_DN; }
                EpiStore<0, 1, 0> E{FB, DM, 0, 1.f, ss, nullptr, nullptr};
                if (xl && k != 5) {
                    const int li = 2 * L + (k == 8);
                    if constexpr (PMASK & 4) run_gemm(lds, A, Bt, TOK, DM, K, E, vc, 0, 2);
                    { EpiSwiGLU E2{ACT, rs};
                      if constexpr (PMASK & 2) run_gemm(lds, HN, WB + (size_t)li * W_FFN_STRIDE + W_GU, TOK, 2 * DFF, DM, E2, vc, 11, 11); }
                    if (local_ok) xcc_barrier(barw, xbar.x, (unsigned)(G / 8)); else xcd_barrier(xbar);
                    if constexpr (PMASK & 4) run_gemm(lds, A, Bt, TOK, DM, K, E, vc, 2, 2);
                } else {
                    if constexpr (PMASK & 4) run_gemm(lds, A, Bt, TOK, DM, K, E, vc);
                }
            } else if (k == 2 || k == 6 || k == 9) {
                const int pi = (k == 2) ? 0 : (k == 6) ? 1 : 2;
                const float* gpost = P.norm_post + (size_t)(L * 3 + pi) * DM;
                const float coef = (k == 6) ? 1.0f : 0.5f;
                if constexpr (PMASK & 8) {
                    const int f0 = xl ? (32 * xx + jj) * 256 + wave : gw, fs = xl ? NWAVES : NGW, fe = xl ? (32 * xx + jj) * 256 + 256 : TOK;
                    if (L == 0 && k == 2) fin_phase<true, false>(P.x, P.out, HN, LO, rs, FB, ss, gpost, coef, f0, fs, fe, lane);
                    else if (L == DEPTH - 1 && k == 9) fin_phase<false, true>(P.x, P.out, HN, LO, rs, FB, ss, gpost, coef, f0, fs, fe, lane);
                    else fin_phase<false, false>(P.x, P.out, HN, LO, rs, FB, ss, gpost, coef, f0, fs, fe, lane);
                }
            } else if (k == 3) {
                if (!mix) {
                    const bf16_t* Wi = WB + W_A0 + (size_t)lm * W_A_STRIDE + W_AIN;
                    EpiStore<1, 0, 1> E1{UB, DM, 0, 1.f, nullptr, nullptr, rs};
                    if constexpr (PMASK & 16) run_gemm(lds, HN, Wi, TOK, DM, DM, E1, vc);
                    EpiStore<1, 2, 2> E2{VTB, ldt, 0, 1.f, vsum, vsq, rs};
                    if constexpr (PMASK & 256) run_gemm(lds, Wi + (size_t)DM * DM, HN, DM, TOK, DM, E2, vc);
                } else {
                    const bf16_t* Wq = WB + W_B0 + (size_t)lm * W_B_STRIDE + W_BQKV;
                    EpiStore<0, 0, 1> E1{QKB, 2 * DM, 4, QSCALE, nullptr, nullptr, rs};
                    if constexpr (PMASK & 32) run_gemm(lds, HN, Wq, TOK, 2 * DM, DM, E1, vc);
                    EpiStore<0, 0, 2> E2{VtB, ldt, 0, 1.f, nullptr, nullptr, rs};
                    if constexpr (PMASK & 32) run_gemm(lds, Wq + (size_t)2 * DM * DM, HN, DM, TOK, DM, E2, vc);
                }
            } else {
                if (!mix) { if constexpr (PMASK & 64) spatial_phase(lds, UB, VTB, vsum, vsq, P.a_lng + (size_t)lm * DM, P.a_ws + (size_t)lm * 8 * 128 * 128, P.a_bs + (size_t)lm * 8 * 128, YB, xl ? 512 * xx + jj : (int)blockIdx.x, xl ? 32 : G, xl ? 512 * (xx + 1) : (TOK / 128) * 8, ldt); }
                else { if constexpr (PMASK & 128) attn_phase(lds, QKB, VtB, YB, xl ? 64 * xx + jj : (int)blockIdx.x, xl ? 32 : G, xl ? 64 * (xx + 1) : NB * NH, ldt); }
            }
        }
        if (ph + 1 < a.ph_hi) {
            if (a.ph_hi > 4096) grid.sync();
            else if (ph == 0 || !local_ok) xcd_barrier(xbar);
            else xcc_barrier(barw, xbar.x, (unsigned)(G / 8));
            if (ph == 0 && xl && xbar.x < 8u) {
                bool even = true;
                for (int j = 0; j < 8; ++j) even = even && (__hip_atomic_load(tick + 64 * j, __ATOMIC_RELAXED, __HIP_MEMORY_SCOPE_AGENT) == (unsigned)(G / 8));
                if (even) { vc = my_ticket * 8 + (int)xbar.x; local_ok = true; } }
        }
    }
}

extern "C" void kernel_launch(void* const* d_in, const int* in_sizes, int n_in, void* d_out, int out_size, void* d_ws, size_t ws_size, hipStream_t stream) {
    static int grid = 0;
    if (grid == 0) {
        if (n_in != 13 || in_sizes[0] != TOK * DM || out_size != TOK * DM || ws_size < WS_END) {
            fprintf(stderr, "kernel_launch: unexpected shapes (n_in %d, in0 %d, out %d, ws %zu need %zu); nothing launched\n", n_in, n_in > 0 ? in_sizes[0] : -1, out_size, ws_size, (size_t)WS_END); grid = -1; return; }
        int dev = 0, cus = 0, per_cu = 0;
        if (hipGetDevice(&dev) != hipSuccess || hipDeviceGetAttribute(&cus, hipDeviceAttributeMultiprocessorCount, dev) != hipSuccess) { fprintf(stderr, "kernel_launch: device query failed\n"); grid = -1; return; }
        if (hipFuncSetAttribute((const void*)fwd_kernel, hipFuncAttributeMaxDynamicSharedMemorySize, LDS_BYTES) != hipSuccess) { fprintf(stderr, "kernel_launch: hipFuncSetAttribute failed\n"); grid = -1; return; }
        if (hipOccupancyMaxActiveBlocksPerMultiprocessor(&per_cu, (const void*)fwd_kernel, NTHREADS, LDS_BYTES) != hipSuccess || per_cu < 1) { fprintf(stderr, "kernel_launch: occupancy query says %d blocks per CU\n", per_cu); per_cu = 1; }
        (void)hipGetLastError();
        grid = cus;
        fprintf(stderr, "kernel_launch: grid %d (cus %d, per_cu %d)\n", grid, cus, per_cu);
    }
    if (grid < 0) return;
    if (hipMemsetAsync((char*)d_ws + WS_BAR, 0, BAR_BYTES, stream) != hipSuccess) { fprintf(stderr, "kernel_launch: hipMemsetAsync failed\n"); return; }
    Args a{};
    const float** pp = (const float**)&a.p;
    for (int i = 0; i < 13; ++i) pp[i] = (const float*)d_in[i];
    a.p.out = (float*)d_out; a.p.ws = (unsigned char*)d_ws;
#if MK_MULTI
    for (int ph = 0; ph < N_PHASES; ++ph) { a.ph_lo = ph; a.ph_hi = ph + 1; hipLaunchKernelGGL(fwd_kernel, dim3(grid), dim3(NTHREADS), LDS_BYTES, stream, a); }
#else
    a.ph_lo = 0; a.ph_hi = N_PHASES;
    void* args[] = {&a};
    const hipError_t e = hipLaunchCooperativeKernel((const void*)fwd_kernel, dim3(grid), dim3(NTHREADS), args, LDS_BYTES, stream);
    if (e != hipSuccess) fprintf(stderr, "kernel_launch: cooperative launch failed: %s (grid %d)\n", hipGetErrorString(e), grid);
#endif
}
```
